# Optimizing an MI355X kernel written in HIP

```python
import math
import jax, jax.numpy as jnp
from jax import lax
import numpy as np

D_MODEL = 2048
BATCH = 16
SEQ = 2048
DEPTH = 4

CHUNK = 64
Q_BLOCK = 128
N_ATT_HEADS = 8
HEAD_DIM = 64
V_HEAD_DIM = 2 * HEAD_DIM
D_ATT_QK = N_ATT_HEADS * 2 * HEAD_DIM
D_ATT_V = N_ATT_HEADS * V_HEAD_DIM
D_SSM = D_MODEL // 2
SSM_GROUP = 16
N_SSM_GROUPS = D_SSM // SSM_GROUP
SSM_STATE = 64
DT_MIN = 1e-3
DT_MAX = 1e-1
D_FF = 5504
CONV_W = 3
N_BRANCH = 2
IN_COLS = 2 * D_ATT_QK + D_ATT_V + D_SSM + N_BRANCH * D_MODEL
EPS = 1e-6

kernel_name = "hybrid_diffattn_s5_convffn_streaming"


def rmsnorm(x, g):
    xf = x.astype(jnp.float32)
    y = xf * lax.rsqrt(jnp.mean(xf * xf, axis=-1, keepdims=True) + EPS)
    return (y * g.astype(jnp.float32)).astype(x.dtype)


def alibi_slopes():
    h = jnp.arange(1, N_ATT_HEADS + 1, dtype=jnp.float32)
    return 2.0 ** (-8.0 * h / N_ATT_HEADS)


def diff_attention(q, k, v, lam):
    b_, s_ = q.shape[0], q.shape[1]
    nblk = s_ // Q_BLOCK
    scale = HEAD_DIM ** -0.5
    kt = k.transpose(0, 2, 3, 1, 4)
    vt = v.transpose(0, 2, 1, 3)
    qb = (q * scale).reshape(b_, nblk, Q_BLOCK, N_ATT_HEADS, 2, HEAD_DIM)
    qb = qb.transpose(1, 0, 3, 4, 2, 5)
    slopes = alibi_slopes()
    kpos = jnp.arange(s_, dtype=jnp.int32)

    def block(args):
        qblk, bi = args
        qpos = bi * Q_BLOCK + jnp.arange(Q_BLOCK, dtype=jnp.int32)
        chunk_end = (qpos // CHUNK + 1) * CHUNK
        visible = kpos[None, :] < chunk_end[:, None]
        dist = jnp.abs(qpos[:, None] - kpos[None, :]).astype(jnp.float32)
        bias = jnp.where(visible[None], -slopes[:, None, None] * dist[None], -jnp.inf)
        s = jnp.einsum('bhcqd,bhcsd->bhcqs', qblk, kt).astype(jnp.float32) + bias[None, :, None]
        p = jax.nn.softmax(s, axis=-1)
        w = (p[:, :, 0] - lam * p[:, :, 1]).astype(vt.dtype)
        return jnp.einsum('bhqs,bhsd->bhqd', w, vt)

    o = lax.map(block, (qb, jnp.arange(nblk, dtype=jnp.int32)))
    return o.transpose(1, 0, 3, 2, 4).reshape(b_, s_, N_ATT_HEADS, V_HEAD_DIM)


def _complex_affine_combine(earlier, later):
    ar1, ai1, br1, bi1 = earlier
    ar2, ai2, br2, bi2 = later
    return (ar2 * ar1 - ai2 * ai1,
            ar2 * ai1 + ai2 * ar1,
            ar2 * br1 - ai2 * bi1 + br2,
            ar2 * bi1 + ai2 * br1 + bi2)


def s5_ssm(u, a_re, a_im, log_dt, b_re, b_im, c_re, c_im, d_skip):
    b_, s_, _ = u.shape
    ug = u.reshape(b_, s_, N_SSM_GROUPS, SSM_GROUP)
    dt = jnp.exp(log_dt)[:, None]
    mag = jnp.exp(dt * a_re)
    ab_re = mag * jnp.cos(dt * a_im)
    ab_im = mag * jnp.sin(dt * a_im)
    den = a_re * a_re + a_im * a_im
    zr = ab_re - 1.0
    zi = ab_im
    f_re = (zr * a_re + zi * a_im) / den
    f_im = (zi * a_re - zr * a_im) / den
    bb_re = f_re[..., None] * b_re - f_im[..., None] * b_im
    bb_im = f_re[..., None] * b_im + f_im[..., None] * b_re
    x_re = jnp.einsum('bsgi,gpi->sbgp', ug, bb_re)
    x_im = jnp.einsum('bsgi,gpi->sbgp', ug, bb_im)
    a_re_s = jnp.broadcast_to(ab_re[None, None], (s_, 1) + ab_re.shape)
    a_im_s = jnp.broadcast_to(ab_im[None, None], (s_, 1) + ab_im.shape)
    _, _, h_re, h_im = lax.associative_scan(
        _complex_affine_combine, (a_re_s, a_im_s, x_re, x_im), axis=0)
    y = (jnp.einsum('sbgp,gop->bsgo', h_re, c_re)
         - jnp.einsum('sbgp,gop->bsgo', h_im, c_im))
    y = y + d_skip.reshape(N_SSM_GROUPS, SSM_GROUP) * ug
    return y.reshape(b_, s_, D_SSM)


def causal_dwconv(x, w, b):
    s_ = x.shape[1]
    xp = jnp.pad(x, ((0, 0), (CONV_W - 1, 0), (0, 0)))
    y = b + xp[:, 0:s_] * w[0]
    for j in range(1, CONV_W):
        y = y + xp[:, j:j + s_] * w[j]
    return y


def setup_inputs(seed: int = 0) -> dict:
    key = jax.random.key(seed)
    ks = jax.random.split(key, 32)
    L, D = DEPTH, D_MODEL
    G, P, I = N_SSM_GROUPS, SSM_STATE, SSM_GROUP
    f32 = jnp.float32
    nrm = lambda k, shape, s: (jax.random.normal(k, shape, f32) * s)
    a_im = jnp.broadcast_to(jnp.pi * jnp.arange(P, dtype=f32), (L, G, P))
    log_dt = jax.random.uniform(ks[10], (L, G), f32, math.log(DT_MIN), math.log(DT_MAX))
    return {
        "x": nrm(ks[0], (BATCH, SEQ, D), 1.0),
        "norm1_g": 1.0 + nrm(ks[1], (L, D), 0.02),
        "w_in": nrm(ks[2], (L, D, IN_COLS), D ** -0.5),
        "q_norm_g": 1.0 + nrm(ks[3], (L, HEAD_DIM), 0.02),
        "k_norm_g": 1.0 + nrm(ks[4], (L, HEAD_DIM), 0.02),
        "lambda_q1": nrm(ks[5], (L, HEAD_DIM), 0.1),
        "lambda_k1": nrm(ks[6], (L, HEAD_DIM), 0.1),
        "lambda_q2": nrm(ks[7], (L, HEAD_DIM), 0.1),
        "lambda_k2": nrm(ks[8], (L, HEAD_DIM), 0.1),
        "subln_g": 1.0 + nrm(ks[9], (L, V_HEAD_DIM), 0.02),
        "ssm_a_re": -0.5 + nrm(ks[11], (L, G, P), 0.01),
        "ssm_a_im": a_im + 0.0,
        "ssm_log_dt": log_dt,
        "ssm_b_re": nrm(ks[12], (L, G, P, I), (2 * I) ** -0.5),
        "ssm_b_im": nrm(ks[13], (L, G, P, I), (2 * I) ** -0.5),
        "ssm_c_re": nrm(ks[14], (L, G, I, P), (2 * P) ** -0.5),
        "ssm_c_im": nrm(ks[15], (L, G, I, P), (2 * P) ** -0.5),
        "ssm_d": nrm(ks[16], (L, D_SSM), 1.0),
        "ssm_glu_w": nrm(ks[17], (L, D_SSM, D_SSM), D_SSM ** -0.5),
        "ssm_glu_b": nrm(ks[18], (L, D_SSM), 0.01),
        "w_branch_attn": nrm(ks[19], (L, D_ATT_V, D), D_ATT_V ** -0.5),
        "w_branch_ssm": nrm(ks[20], (L, D_SSM, D), D_SSM ** -0.5),
        "w_out": nrm(ks[21], (L, D, D), D ** -0.5),
        "norm2_g": 1.0 + nrm(ks[22], (L, D), 0.02),
        "ffn_w_up": nrm(ks[23], (L, D, 2 * D_FF), D ** -0.5),
        "ffn_conv_w": nrm(ks[24], (L, CONV_W, 2 * D_FF), CONV_W ** -0.5),
        "ffn_conv_b": nrm(ks[25], (L, 2 * D_FF), 0.01),
        "ffn_w_down": nrm(ks[26], (L, D_FF, D), D_FF ** -0.5),
    }


def reference(x, norm1_g, w_in, q_norm_g, k_norm_g, lambda_q1, lambda_k1, lambda_q2,
              lambda_k2, subln_g, ssm_a_re, ssm_a_im, ssm_log_dt, ssm_b_re, ssm_b_im,
              ssm_c_re, ssm_c_im, ssm_d, ssm_glu_w, ssm_glu_b, w_branch_attn,
              w_branch_ssm, w_out, norm2_g, ffn_w_up, ffn_conv_w, ffn_conv_b, ffn_w_down):
    b_, s_, _ = x.shape
    splits = [D_ATT_QK, 2 * D_ATT_QK, 2 * D_ATT_QK + D_ATT_V, 2 * D_ATT_QK + D_ATT_V + D_SSM,
              2 * D_ATT_QK + D_ATT_V + D_SSM + D_MODEL]
    for l in range(DEPTH):
        lam_init = 0.8 - 0.6 * math.exp(-0.3 * l)
        h = rmsnorm(x, norm1_g[l])
        proj = h @ w_in[l]
        q, k, v, u, g_att, g_ssm = jnp.split(proj, splits, axis=-1)
        q = rmsnorm(q.reshape(b_, s_, N_ATT_HEADS, 2, HEAD_DIM), q_norm_g[l])
        k = rmsnorm(k.reshape(b_, s_, N_ATT_HEADS, 2, HEAD_DIM), k_norm_g[l])
        v = v.reshape(b_, s_, N_ATT_HEADS, V_HEAD_DIM)
        lam = (jnp.exp(jnp.sum(lambda_q1[l].astype(jnp.float32) * lambda_k1[l].astype(jnp.float32)))
               - jnp.exp(jnp.sum(lambda_q2[l].astype(jnp.float32) * lambda_k2[l].astype(jnp.float32)))
               + lam_init)
        o = diff_attention(q, k, v, lam)
        o = rmsnorm(o, subln_g[l]) * (1.0 - lam_init)
        o_att = o.reshape(b_, s_, D_ATT_V) @ w_branch_attn[l]

        y = s5_ssm(u, ssm_a_re[l], ssm_a_im[l], ssm_log_dt[l], ssm_b_re[l], ssm_b_im[l],
                   ssm_c_re[l], ssm_c_im[l], ssm_d[l])
        y = jax.nn.gelu(y)
        y = y * jax.nn.sigmoid(y @ ssm_glu_w[l] + ssm_glu_b[l])
        o_ssm = y @ w_branch_ssm[l]

        mixed = jax.nn.sigmoid(g_att) * o_att + jax.nn.sigmoid(g_ssm) * o_ssm
        x = x + mixed @ w_out[l]

        h = rmsnorm(x, norm2_g[l])
        up = causal_dwconv(h @ ffn_w_up[l], ffn_conv_w[l], ffn_conv_b[l])
        a, val = jnp.split(up, 2, axis=-1)
        x = x + (jax.nn.gelu(a) * val) @ ffn_w_down[l]
    return x
```

```cpp
#include <hip/hip_runtime.h>
#include <cstdio>
#include <cstdint>
namespace pg8 {
#define PG8_LAS __attribute__((address_space(3)))
typedef unsigned short bf16_t;
typedef short bf16x8 __attribute__((ext_vector_type(8)));
typedef float f32x4 __attribute__((ext_vector_type(4)));
typedef unsigned u32x4 __attribute__((ext_vector_type(4)));
constexpr int BM = 256, BK = 64, HALF = 128, HTB = HALF * BK * 2  , STAGE_BYTES = 8 * HTB, NXCD = 8, WGM = 8;

__host__ __device__ __forceinline__ int lds_byte(int r, int c) { const int st = (r >> 4) * 2 + (c >> 5), rr = r & 15, cc = c & 31, ob = rr * 64 + cc * 2; return st * 1024 + (ob ^ (((ob >> 9) & 1) << 5)); }
__host__ __device__ __forceinline__ void stage_rc(int b, int& R, int& C) { const int st = b / 1024, sb = b % 1024, swz = sb ^ (((sb >> 9) & 1) << 5); R = (st >> 1) * 16 + swz / 64; C = (st & 1) * 32 + (swz % 64) / 2; }
__host__ __device__ __forceinline__ int perm32(int rho) { const int n = rho >> 4, i = rho & 15; return 8 * (i >> 2) + 4 * n + (i & 3); }

struct Unit { int pm, pn; };
struct Gemm { const bf16_t* A; const bf16_t* Bt; int M, N, K; };

struct StaticOrder {
    int nM, nN, nwg, G, c;
    __host__ __device__ void init(int M, int N, int G_, int c_) { nM = M / BM; nN = N / BM; nwg = nM * nN; G = G_; c = c_; }
    __host__ __device__ bool next(int i, Unit& u) const {
        const long L = (long)i * G + c; if (L >= nwg) return false;
        int wgid = (int)L; { const int q = nwg / NXCD, r = nwg % NXCD, xcd = wgid % NXCD, off = wgid / NXCD; wgid = (xcd < r ? xcd * (q + 1) : r * (q + 1) + (xcd - r) * q) + off; }
        const int nig = WGM * nN, gid = wgid / nig, fm = gid * WGM, gsz = (nM - fm) < WGM ? (nM - fm) : WGM;
        u.pm = fm + ((wgid % nig) % gsz); u.pn = (wgid % nig) / gsz; return true;
    }
    __device__ __forceinline__ void a_ready(const Unit&) const {}
    __device__ __forceinline__ void done(const Unit&) const {}
};

__device__ __forceinline__ unsigned cvt_pk_bf16(float lo, float hi) { unsigned r; asm volatile("v_cvt_pk_bf16_f32 %0, %1, %2" : "=v"(r) : "v"(lo), "v"(hi)); return r; }
typedef float f32x2 __attribute__((ext_vector_type(2)));
__device__ __forceinline__ f32x2 gelu_pk(f32x2 v) {
    const f32x2 av = __builtin_elementwise_abs(v), d = av * 0.2316418882f + 1.0f;
    f32x2 t; t.x = __builtin_amdgcn_rcpf(d.x); t.y = __builtin_amdgcn_rcpf(d.y);
    f32x2 q = t * 0.5307027145f + (-0.7265760135f); q = q * t + 0.7107068705f; q = q * t + (-0.142248368f); q = q * t + 0.127414796f; q = q * t;
    const f32x2 s = (v * v) * (-0.72134752044f);
    f32x2 e; e.x = __builtin_amdgcn_exp2f(s.x); e.y = __builtin_amdgcn_exp2f(s.y);
    const f32x2 m = v * (q * e), r = v - m;
    f32x2 o; o.x = v.x < 0.f ? m.x : r.x; o.y = v.y < 0.f ? m.y : r.y; return o;
}

__device__ __forceinline__ float bf_lo(unsigned w) { return __uint_as_float(w << 16); }
__device__ __forceinline__ float bf_hi(unsigned w) { return __uint_as_float(w & 0xffff0000u); }
__device__ __forceinline__ float sigm(float z) { return __builtin_amdgcn_rcpf(1.0f + __builtin_amdgcn_exp2f(-1.4426950408889634f * z)); }
__device__ __forceinline__ float gelu_t(float x) { const float u = x * (1.0f + 0.044715f * x * x); return x * __builtin_amdgcn_rcpf(1.0f + __builtin_amdgcn_exp2f(-2.302208198f * u)); }

struct EpiScaleBf16 { static constexpr bool PERM = true, AFTER_DRAIN = false;
    bf16_t* O; int ldc; const float* rs;
    __device__ __forceinline__ void operator()(const f32x4 (&acc)[2][2][4][2], const Unit& u, int wr, int wc, int fr, int fq) const {
        const int row0 = u.pm * BM + wr * 64 + fr, col0 = u.pn * BM + wc * 32 + 8 * fq;
#pragma unroll
        for (int ai = 0; ai < 2; ++ai)
#pragma unroll
            for (int m = 0; m < 4; ++m) { const int row = row0 + ai * HALF + m * 16; const float s = rs[row]; bf16_t* rowp = O + (size_t)row * ldc + col0;
#pragma unroll
                for (int bj = 0; bj < 2; ++bj) { const f32x4 v0 = acc[ai][bj][m][0] * s, v1 = acc[ai][bj][m][1] * s;
                    u32x4 w; w.x = cvt_pk_bf16(v0[0], v0[1]); w.y = cvt_pk_bf16(v0[2], v0[3]); w.z = cvt_pk_bf16(v1[0], v1[1]); w.w = cvt_pk_bf16(v1[2], v1[3]);
                    *(u32x4*)(rowp + bj * HALF) = w; } }
    }
};
struct EpiGlu { static constexpr bool PERM = true, AFTER_DRAIN = false;
    bf16_t* O; const bf16_t* Y; int ld; const float* bias;
    __device__ __forceinline__ void operator()(const f32x4 (&acc)[2][2][4][2], const Unit& u, int wr, int wc, int fr, int fq) const {
        const int row0 = u.pm * BM + wr * 64 + fr, col0 = u.pn * BM + wc * 32 + 8 * fq;
        f32x4 bv[2][2];
#pragma unroll
        for (int bj = 0; bj < 2; ++bj)
#pragma unroll
            for (int n = 0; n < 2; ++n) bv[bj][n] = *(const f32x4*)(bias + col0 + bj * HALF + 4 * n);
#pragma unroll
        for (int ai = 0; ai < 2; ++ai)
#pragma unroll
            for (int m = 0; m < 4; ++m) { const size_t off = (size_t)(row0 + ai * HALF + m * 16) * ld + col0;
#pragma unroll
                for (int bj = 0; bj < 2; ++bj) { const f32x4 z0 = acc[ai][bj][m][0] + bv[bj][0], z1 = acc[ai][bj][m][1] + bv[bj][1];
                    const u32x4 y = *(const u32x4*)(Y + off + bj * HALF);
                    u32x4 w; w.x = cvt_pk_bf16(bf_lo(y.x) * sigm(z0[0]), bf_hi(y.x) * sigm(z0[1])); w.y = cvt_pk_bf16(bf_lo(y.y) * sigm(z0[2]), bf_hi(y.y) * sigm(z0[3]));
                    w.z = cvt_pk_bf16(bf_lo(y.z) * sigm(z1[0]), bf_hi(y.z) * sigm(z1[1])); w.w = cvt_pk_bf16(bf_lo(y.w) * sigm(z1[2]), bf_hi(y.w) * sigm(z1[3]));
                    *(u32x4*)(O + off + bj * HALF) = w; } }
    }
};
struct EpiGate1 { static constexpr bool PERM = true, AFTER_DRAIN = false;
    float* T; int ldt; const bf16_t* gate; int ldg;
    __device__ __forceinline__ void operator()(const f32x4 (&acc)[2][2][4][2], const Unit& u, int wr, int wc, int fr, int fq) const {
        const int row0 = u.pm * BM + wr * 64 + fr, col0 = u.pn * BM + wc * 32 + 8 * fq;
#pragma unroll
        for (int ai = 0; ai < 2; ++ai)
#pragma unroll
            for (int m = 0; m < 4; ++m) { const int row = row0 + ai * HALF + m * 16;
#pragma unroll
                for (int bj = 0; bj < 2; ++bj) { const u32x4 g = *(const u32x4*)(gate + (size_t)row * ldg + col0 + bj * HALF);
                    const f32x4 a0 = acc[ai][bj][m][0], a1 = acc[ai][bj][m][1];
                    f32x4 o0, o1; o0[0] = sigm(bf_lo(g.x)) * a0[0]; o0[1] = sigm(bf_hi(g.x)) * a0[1]; o0[2] = sigm(bf_lo(g.y)) * a0[2]; o0[3] = sigm(bf_hi(g.y)) * a0[3];
                    o1[0] = sigm(bf_lo(g.z)) * a1[0]; o1[1] = sigm(bf_hi(g.z)) * a1[1]; o1[2] = sigm(bf_lo(g.w)) * a1[2]; o1[3] = sigm(bf_hi(g.w)) * a1[3];
                    float* tp = T + (size_t)row * ldt + col0 + bj * HALF; *(f32x4*)tp = o0; *(f32x4*)(tp + 4) = o1; } }
    }
};
struct EpiGate2 { static constexpr bool PERM = true, AFTER_DRAIN = false;
    bf16_t* O; int ldo; const float* T; int ldt; const bf16_t* gate; int ldg;
    __device__ __forceinline__ void operator()(const f32x4 (&acc)[2][2][4][2], const Unit& u, int wr, int wc, int fr, int fq) const {
        const int row0 = u.pm * BM + wr * 64 + fr, col0 = u.pn * BM + wc * 32 + 8 * fq;
#pragma unroll
        for (int ai = 0; ai < 2; ++ai)
#pragma unroll
            for (int m = 0; m < 4; ++m) { const int row = row0 + ai * HALF + m * 16;
#pragma unroll
                for (int bj = 0; bj < 2; ++bj) { const u32x4 g = *(const u32x4*)(gate + (size_t)row * ldg + col0 + bj * HALF);
                    const float* tp = T + (size_t)row * ldt + col0 + bj * HALF; const f32x4 t0 = *(const f32x4*)tp, t1 = *(const f32x4*)(tp + 4);
                    const f32x4 a0 = acc[ai][bj][m][0], a1 = acc[ai][bj][m][1];
                    u32x4 w; w.x = cvt_pk_bf16(t0[0] + sigm(bf_lo(g.x)) * a0[0], t0[1] + sigm(bf_hi(g.x)) * a0[1]); w.y = cvt_pk_bf16(t0[2] + sigm(bf_lo(g.y)) * a0[2], t0[3] + sigm(bf_hi(g.y)) * a0[3]);
                    w.z = cvt_pk_bf16(t1[0] + sigm(bf_lo(g.z)) * a1[0], t1[1] + sigm(bf_hi(g.z)) * a1[1]); w.w = cvt_pk_bf16(t1[2] + sigm(bf_lo(g.w)) * a1[2], t1[3] + sigm(bf_hi(g.w)) * a1[3]);
                    *(u32x4*)(O + (size_t)row * ldo + col0 + bj * HALF) = w; } }
    }
};
struct EpiResid { static constexpr bool PERM = false, AFTER_DRAIN = false;
    float* X; int ld;
    __device__ __forceinline__ void operator()(const f32x4 (&acc)[2][2][4][2], const Unit& u, int wr, int wc, int fr, int fq) const {
        const int row0 = u.pm * BM + wr * 64 + fr, col0 = u.pn * BM + wc * 32 + 4 * fq;
#pragma unroll
        for (int ai = 0; ai < 2; ++ai)
#pragma unroll
            for (int m = 0; m < 4; ++m) { float* rowp = X + (size_t)(row0 + ai * HALF + m * 16) * ld + col0;
#pragma unroll
                for (int bj = 0; bj < 2; ++bj)
#pragma unroll
                    for (int n = 0; n < 2; ++n) { float* p = rowp + bj * HALF + n * 16; *(f32x4*)p = *(const f32x4*)p + acc[ai][bj][m][n]; } }
    }
};

template <class Epi, class Sched, bool ALIGN_EPI = false, bool SP2 = false>
__device__ __forceinline__ void gemm_phase(PG8_LAS unsigned char* lds, const Gemm g, const Sched& S, const Epi& E) {
    int tid_ = threadIdx.x; asm volatile("" : "+v"(tid_));
    const int tid = tid_, wid = __builtin_amdgcn_readfirstlane(tid >> 6), lane = tid & 63, wr = wid >> 2, wc = wid & 3, fr = lane & 15, fq = lane >> 4;
    const int K = g.K, nt = K / BK;
    unsigned voffA[2], voffB[2];
#pragma unroll
    for (int i = 0; i < 2; ++i) { int R, C; stage_rc(tid * 16 + i * 8192, R, C); const int Rb = Epi::PERM ? ((R & ~31) + perm32(R & 31)) : R;
        voffA[i] = (unsigned)(R * K + C) * 2u; voffB[i] = (unsigned)(Rb * K + C) * 2u; }
    const size_t kstep = (size_t)(BK * 2);
    const size_t hstep = (size_t)HALF * K * 2;
    const size_t tstep = 2 * hstep;
    const unsigned ldsw = (unsigned)wid * 1024u;
    const int aoff = lds_byte(wr * 64 + fr, fq * 8), boff = lds_byte(wc * 32 + fr, fq * 8);
#define PG8_SA(b, h) (((b) * 2 + (h)) * HTB)
#define PG8_SB(b, h) ((4 + (b) * 2 + (h)) * HTB)
#define PG8_STAGE(bufoff, gbase, voff) do { _Pragma("unroll") for (int _i = 0; _i < 2; ++_i) \
        __builtin_amdgcn_global_load_lds((const unsigned*)((const char*)(gbase) + (voff)[_i]), (PG8_LAS unsigned*)(lds + (bufoff) + ldsw + _i * 8192), 16, 0, 0); } while (0)
#define PG8_LDA(dst, b, h) do { _Pragma("unroll") for (int m = 0; m < 4; ++m) _Pragma("unroll") for (int k = 0; k < 2; ++k) dst[m][k] = *(const PG8_LAS bf16x8*)(lds + PG8_SA(b, h) + aoff + m * 2048 + k * 1024); } while (0)
#define PG8_LDB(dst, b, h) do { _Pragma("unroll") for (int n = 0; n < 2; ++n) _Pragma("unroll") for (int k = 0; k < 2; ++k) dst[n][k] = *(const PG8_LAS bf16x8*)(lds + PG8_SB(b, h) + boff + n * 2048 + k * 1024); } while (0)
#define PG8_MMA(ai, bj, At, Bt) do { __builtin_amdgcn_s_setprio(1); _Pragma("unroll") for (int m = 0; m < 4; ++m) _Pragma("unroll") for (int n = 0; n < 2; ++n) _Pragma("unroll") for (int k = 0; k < 2; ++k) \
        acc[ai][bj][m][n] = __builtin_amdgcn_mfma_f32_16x16x32_bf16(Bt[n][k], At[m][k], acc[ai][bj][m][n], 0, 0, 0); __builtin_amdgcn_s_setprio(0); } while (0)
#define PG8_WAIT_V(n) asm volatile("s_waitcnt vmcnt(" #n ")" ::: "memory")
#define PG8_WAIT_L(n) asm volatile("s_waitcnt lgkmcnt(" #n ")" ::: "memory")
#define PG8_BAR __builtin_amdgcn_s_barrier()
#define PG8_SCHED __builtin_amdgcn_sched_barrier(0)
    Unit cur, nxt; int ui = 0;
    if (!S.next(0, cur)) return;
    f32x4 acc[2][2][4][2];
#pragma unroll
    for (int a = 0; a < 2; ++a)
#pragma unroll
        for (int b = 0; b < 2; ++b)
#pragma unroll
            for (int m = 0; m < 4; ++m)
#pragma unroll
                for (int n = 0; n < 2; ++n) acc[a][b][m][n] = (f32x4){0.f, 0.f, 0.f, 0.f};
    bf16x8 At[4][2], B0[2][2], B1[2][2];
    const char* cA = (const char*)g.A + (size_t)cur.pm * tstep; const char* cB = (const char*)g.Bt + (size_t)cur.pn * tstep;
    S.a_ready(cur);
    if constexpr (SP2) {
        PG8_STAGE(PG8_SB(0, 0), cB, voffB); PG8_STAGE(PG8_SB(0, 1), cB + hstep, voffB); PG8_STAGE(PG8_SA(0, 0), cA, voffA); PG8_STAGE(PG8_SA(0, 1), cA + hstep, voffA);
        if (wr == 1) PG8_BAR;
        PG8_WAIT_V(2); PG8_BAR;
        PG8_STAGE(PG8_SB(1, 0), cB + kstep, voffB); PG8_STAGE(PG8_SA(1, 0), cA + kstep, voffA); PG8_STAGE(PG8_SB(1, 1), cB + hstep + kstep, voffB);
        PG8_WAIT_V(6); PG8_BAR;
    } else {
        PG8_STAGE(PG8_SB(0, 0), cB, voffB); PG8_STAGE(PG8_SA(0, 0), cA, voffA); PG8_STAGE(PG8_SB(0, 1), cB + hstep, voffB); PG8_STAGE(PG8_SA(0, 1), cA + hstep, voffA);
        if (wr == 1) PG8_BAR;
        PG8_WAIT_V(4); PG8_BAR;
        PG8_STAGE(PG8_SB(1, 0), cB + kstep, voffB); PG8_STAGE(PG8_SA(1, 0), cA + kstep, voffA); PG8_STAGE(PG8_SB(1, 1), cB + hstep + kstep, voffB);
        PG8_WAIT_V(6); PG8_BAR;
    }
    for (;;) {
        const bool has_next = S.next(ui + 1, nxt);
        const char* nA = has_next ? (const char*)g.A + (size_t)nxt.pm * tstep : cA; const char* nB = has_next ? (const char*)g.Bt + (size_t)nxt.pn * tstep : cB;
        for (int t = 0; t < nt; t += 2) {
            const bool last = (t == nt - 2);
            const char* a1 = cA + (size_t)(t + 1) * kstep;
            const char* a2 = last ? nA : cA + (size_t)(t + 2) * kstep; const char* b2 = last ? nB : cB + (size_t)(t + 2) * kstep;
            const char* a3 = a2 + kstep; const char* b3 = b2 + kstep;
            if (last && has_next) S.a_ready(nxt);
            if constexpr (SP2) {
            PG8_LDB(B0, 0, 0); PG8_LDB(B1, 0, 1); PG8_SCHED; PG8_LDA(At, 0, 0); PG8_STAGE(PG8_SA(1, 1), a1 + hstep, voffA);
            PG8_WAIT_V(8); PG8_WAIT_L(0); PG8_BAR; PG8_MMA(0, 0, At, B0); PG8_MMA(0, 1, At, B1); PG8_BAR; PG8_SCHED;
            PG8_LDA(At, 0, 1); PG8_STAGE(PG8_SB(0, 0), b2, voffB); PG8_STAGE(PG8_SB(0, 1), b2 + hstep, voffB); PG8_STAGE(PG8_SA(0, 0), a2, voffA);
            PG8_WAIT_V(8); PG8_WAIT_L(0); PG8_BAR; PG8_MMA(1, 0, At, B0); PG8_MMA(1, 1, At, B1); PG8_BAR; PG8_SCHED;
            PG8_LDB(B0, 1, 0); PG8_LDB(B1, 1, 1); PG8_SCHED; PG8_LDA(At, 1, 0); PG8_STAGE(PG8_SA(0, 1), a2 + hstep, voffA);
            PG8_WAIT_V(8); PG8_WAIT_L(0); PG8_BAR; PG8_MMA(0, 0, At, B0); PG8_MMA(0, 1, At, B1); PG8_BAR; PG8_SCHED;
            PG8_LDA(At, 1, 1); PG8_STAGE(PG8_SB(1, 0), b3, voffB); PG8_STAGE(PG8_SB(1, 1), b3 + hstep, voffB); PG8_STAGE(PG8_SA(1, 0), a3, voffA);
            PG8_WAIT_V(8); PG8_WAIT_L(0); PG8_BAR; PG8_MMA(1, 0, At, B0); PG8_MMA(1, 1, At, B1); PG8_BAR; PG8_SCHED;
            } else {
            PG8_LDB(B0, 0, 0); PG8_SCHED; PG8_LDA(At, 0, 0); PG8_STAGE(PG8_SA(1, 1), a1 + hstep, voffA);
            PG8_WAIT_L(8); PG8_BAR; PG8_WAIT_L(0); PG8_MMA(0, 0, At, B0); PG8_BAR; PG8_SCHED;
            PG8_LDB(B1, 0, 1); PG8_STAGE(PG8_SB(0, 0), b2, voffB);
            PG8_BAR; PG8_WAIT_L(0); PG8_MMA(0, 1, At, B1); PG8_BAR;
            PG8_LDA(At, 0, 1); PG8_STAGE(PG8_SA(0, 0), a2, voffA);
            PG8_BAR; PG8_WAIT_L(0); PG8_MMA(1, 0, At, B0); PG8_BAR; PG8_SCHED;
            PG8_STAGE(PG8_SB(0, 1), b2 + hstep, voffB);
            PG8_WAIT_V(6); PG8_BAR; PG8_MMA(1, 1, At, B1); PG8_BAR;
            PG8_LDB(B0, 1, 0); PG8_SCHED; PG8_LDA(At, 1, 0); PG8_STAGE(PG8_SA(0, 1), a2 + hstep, voffA);
            PG8_WAIT_L(8); PG8_BAR; PG8_WAIT_L(0); PG8_MMA(0, 0, At, B0); PG8_BAR; PG8_SCHED;
            PG8_LDB(B1, 1, 1); PG8_STAGE(PG8_SB(1, 0), b3, voffB);
            PG8_BAR; PG8_WAIT_L(0); PG8_MMA(0, 1, At, B1); PG8_BAR;
            PG8_LDA(At, 1, 1); PG8_STAGE(PG8_SA(1, 0), a3, voffA);
            PG8_BAR; PG8_WAIT_L(0); PG8_MMA(1, 0, At, B0); PG8_BAR; PG8_SCHED;
            PG8_STAGE(PG8_SB(1, 1), b3 + hstep, voffB);
            PG8_WAIT_V(6); PG8_BAR; PG8_MMA(1, 1, At, B1); PG8_BAR;
            }
        }
        if constexpr (ALIGN_EPI) { if (wr == 0) PG8_BAR; }
        if constexpr (!Epi::AFTER_DRAIN) { E(acc, cur, wr, wc, fr, fq); S.done(cur); }
        if (!has_next) break;
#pragma unroll
        for (int a = 0; a < 2; ++a)
#pragma unroll
            for (int b = 0; b < 2; ++b)
#pragma unroll
                for (int m = 0; m < 4; ++m)
#pragma unroll
                    for (int n = 0; n < 2; ++n) acc[a][b][m][n] = (f32x4){0.f, 0.f, 0.f, 0.f};
        cur = nxt; cA = nA; cB = nB; ++ui;
        if constexpr (ALIGN_EPI) { if (wr == 1) PG8_BAR; }
    }
    PG8_WAIT_V(0);
    if constexpr (!ALIGN_EPI) { if (wr == 0) PG8_BAR; }
    PG8_BAR;
    if constexpr (Epi::AFTER_DRAIN) { E.fused(acc, cur, wr, wc, fr, fq, lds, wid, lane); S.done(cur); }
#undef PG8_SA
#undef PG8_SB
#undef PG8_STAGE
#undef PG8_LDA
#undef PG8_LDB
#undef PG8_MMA
#undef PG8_WAIT_V
#undef PG8_WAIT_L
#undef PG8_BAR
#undef PG8_SCHED
}
}
constexpr int NWAVES = 8, NTHR = NWAVES * 64;
constexpr int NL = 4, NB = 16, SEQ = 2048, DM = 2048, MR = NB * SEQ;
constexpr int NIN = 8192, DFF = 5504, NUP = 2 * DFF, DS = 1024, NG = 64, NPS = 64, NIS = 16, NH = 8;
constexpr int OFF_K = 1024, OFF_V = 2048, OFF_U = 3072, OFF_GA = 4096, OFF_GS = 6144;
constexpr float EPS = 1e-6f, LOG2E = 1.4426950408889634f, QSCALE = 0.125f * LOG2E;
constexpr int PH_PER_LAYER = 11, N_PHASES = 1 + NL * PH_PER_LAYER;

constexpr size_t MiB = 1u << 20;
constexpr size_t WS_CTL = 0, CTL_ZERO_BYTES = 1 * MiB;
constexpr size_t WS_WIN = 2 * MiB, WS_WGLU = 34 * MiB, WS_WBA = 36 * MiB, WS_WBS = 40 * MiB, WS_WOUT = 44 * MiB, WS_WUP = 52 * MiB, WS_WDN = 95 * MiB;
constexpr size_t WS_RSTD = 118 * MiB;
constexpr size_t WS_XB = 120 * MiB;
constexpr size_t WS_PROJ = 248 * MiB;
constexpr size_t WS_YG = 760 * MiB, WS_Y2 = 824 * MiB, WS_ON = 888 * MiB;
constexpr size_t WS_MIX = 952 * MiB;
constexpr size_t WS_UP = 248 * MiB;
constexpr size_t WS_G = 936 * MiB;
constexpr size_t WS_END = 1280 * MiB;
constexpr int CW_BAR = 4096;

constexpr int RING_BYTES = 131072, LDSCTL_OFF = RING_BYTES, MISC_OFF = LDSCTL_OFF + 320, LDS_BYTES = 147456;

#define GAS __attribute__((address_space(1)))
#define LAS __attribute__((address_space(3)))
typedef unsigned short bf16;
typedef unsigned v4u __attribute__((ext_vector_type(4)));
typedef float f32x4 __attribute__((ext_vector_type(4)));
typedef short bf16x8 __attribute__((ext_vector_type(8)));
typedef GAS unsigned gu32;
typedef GAS unsigned long long gu64;
#define RLX_AGENT __ATOMIC_RELAXED, __HIP_MEMORY_SCOPE_AGENT
#define LDS_WAIT() asm volatile("s_waitcnt lgkmcnt(0)" ::: "memory")
#define VM_WAIT() asm volatile("s_waitcnt vmcnt(0)" ::: "memory")
__device__ __forceinline__ unsigned long long rt() { return __builtin_amdgcn_s_memrealtime(); }
__device__ __forceinline__ unsigned f2bf(float f) { unsigned u = __builtin_bit_cast(unsigned, f); return (u + 0x7fffu + ((u >> 16) & 1u)) >> 16; }
__device__ __forceinline__ unsigned pk2(float lo, float hi) { return f2bf(lo) | (f2bf(hi) << 16); }

#define XB_TMO      128
#define XB_XCNT(j)  (256  + 64 * (j))
#define XB_XSUB(j)  (1280 + 64 * (j))
#define XB_XGEN(j)  (2304 + 64 * (j))
#define XB_TOP      3328
#define XB_TOPGEN   3392
#define XCD_BAR_WORDS 3456
#define XB_SPIN_CAP (1u << 18)

__device__ __forceinline__ unsigned xb_ld(unsigned* p)              { return __hip_atomic_load(p, __ATOMIC_RELAXED, __HIP_MEMORY_SCOPE_AGENT); }
__device__ __forceinline__ unsigned xb_add(unsigned* p, unsigned v) { return __hip_atomic_fetch_add(p, v, __ATOMIC_RELAXED, __HIP_MEMORY_SCOPE_AGENT); }
__device__ __forceinline__ unsigned xb_xcc_id() { return (unsigned)__builtin_amdgcn_s_getreg((3 << 11) | 20) & 0xFu; }
#define XB_SPIN(cond, bar) do { unsigned _sp = 0; while (cond) { __builtin_amdgcn_s_sleep(1); \
    if ((++_sp & 255u) == 0u) { if (xb_ld(&(bar)[XB_TMO])) break; if (_sp > XB_SPIN_CAP) { atomicAdd(&(bar)[XB_TMO], 1u); break; } } } } while (0)

struct XcdBarrier {
    unsigned* bar; unsigned x;
    volatile LAS unsigned* st;
};

__device__ __forceinline__ XcdBarrier xcd_barrier_post(unsigned* bar, volatile LAS unsigned* st) {
    XcdBarrier b; b.bar = bar; b.x = xb_xcc_id(); b.st = st;
    if (threadIdx.x == 0) (void)xb_add(&bar[XB_XCNT(b.x)], 1u);
    return b;
}
__device__ __forceinline__ void xcd_barrier_complete(unsigned* bar, unsigned x, unsigned& nloc, unsigned& nx) {
    const unsigned G = gridDim.x * gridDim.y * gridDim.z;
    unsigned sum, cnt, mine, sp = 0u;
    for (;;) {
        sum = 0u; cnt = 0u; mine = 0u;
#pragma unroll
        for (unsigned j = 0; j < 16; ++j) { const unsigned c = xb_ld(&bar[XB_XCNT(j)]); sum += c; cnt += (c > 0u) ? 1u : 0u; mine = (j == x) ? c : mine; }
        if (sum == G) break;
        __builtin_amdgcn_s_sleep(1);
        if ((++sp & 255u) == 0u) { if (xb_ld(&bar[XB_TMO])) break; if (sp > XB_SPIN_CAP) { atomicAdd(&bar[XB_TMO], 1u); break; } }
    }
    nloc = mine > 0u ? mine : 1u; nx = cnt > 0u ? cnt : 1u;
}

__device__ __forceinline__ void xcd_barrier(const XcdBarrier& b) {
    asm volatile("s_waitcnt vmcnt(0)" ::: "memory");
    __syncthreads();
    if (threadIdx.x == 0) {
        unsigned* bar = b.bar;
        __builtin_amdgcn_s_waitcnt(0);
        unsigned nloc = b.st[0], nx = b.st[1];
        if (nloc == 0u) { xcd_barrier_complete(bar, b.x, nloc, nx); b.st[0] = nloc; b.st[1] = nx; }
        const unsigned old = xb_add(&bar[XB_XSUB(b.x)], 1u);
        const unsigned gen = old / nloc;
        if (old + 1u == (gen + 1u) * nloc) {
            __builtin_amdgcn_fence(__ATOMIC_RELEASE, "agent");
            asm volatile("s_waitcnt vmcnt(0)" ::: "memory");
            const unsigned og = xb_add(&bar[XB_TOP], 1u);
            const unsigned tg = og / nx;
            if (og + 1u == (tg + 1u) * nx) xb_add(&bar[XB_TOPGEN], 1u);
            else XB_SPIN(xb_ld(&bar[XB_TOPGEN]) == tg, bar);
            __builtin_amdgcn_fence(__ATOMIC_ACQUIRE, "agent");
            xb_add(&bar[XB_XGEN(b.x)], 1u);
            asm volatile("s_waitcnt vmcnt(0)" ::: "memory");
        } else {
            XB_SPIN(xb_ld(&bar[XB_XGEN(b.x)]) == gen, bar);
            __builtin_amdgcn_fence(__ATOMIC_ACQUIRE, "agent");
            asm volatile("s_waitcnt vmcnt(0)" ::: "memory");
        }
    }
    __syncthreads();
}
using pg8::bf_lo; using pg8::bf_hi; using pg8::sigm; using pg8::gelu_t;
struct Args { const float* in[28]; float* out; unsigned char* ws; int ph_lo, ph_hi; };
typedef const __attribute__((address_space(4))) Args* KArgsP;
__device__ __forceinline__ KArgsP fresh_args() { KArgsP p = (KArgsP)__builtin_amdgcn_kernarg_segment_ptr(); asm volatile("" : "+s"(p)); return p; }

__device__ __forceinline__ float wave_sum(float v) {
#pragma unroll
    for (int o = 1; o < 64; o <<= 1) v += __shfl_xor(v, o);
    return v;
}
__device__ __forceinline__ void transpose_item(const float* W, int K, int N, const float* gk, bf16* WT, LAS float* scr, int item, int lane) {
    const int nblk = N / 32, kb = item / nblk, nb = item % nblk, k0 = 64 * kb, n0 = 32 * nb;
#pragma unroll 8
    for (int i = 0; i < 32; ++i) { const int kk = 2 * i + (lane >> 5); float w = W[(size_t)(k0 + kk) * N + n0 + (lane & 31)]; if (gk) w *= gk[k0 + kk]; scr[kk * 33 + (lane & 31)] = w; }
    LDS_WAIT(); asm volatile("" ::: "memory");
    const int c = lane & 7;
#pragma unroll
    for (int j = 0; j < 4; ++j) { const int n = (lane >> 3) + 8 * j; const LAS float* s = scr + (8 * c) * 33 + n;
        v4u o; o.x = pk2(s[0 * 33], s[1 * 33]); o.y = pk2(s[2 * 33], s[3 * 33]); o.z = pk2(s[4 * 33], s[5 * 33]); o.w = pk2(s[6 * 33], s[7 * 33]);
        *(GAS v4u*)(WT + (size_t)(n0 + n) * K + k0 + 8 * c) = o; }
    LDS_WAIT(); asm volatile("" ::: "memory");
}
__device__ __forceinline__ void ph_convert(KArgsP ap, LAS unsigned char* lds, int l, int gw, int NGW, int wave, int lane) {
    LAS float* scr = (LAS float*)(lds + wave * 16384);
    unsigned char* ws = ap->ws;
    constexpr int I_IN = (DM / 64) * (NIN / 32), I_GLU = (DS / 64) * (DS / 32), I_BA = (DS / 64) * (DM / 32), I_OUT = (DM / 64) * (DM / 32), I_UP = (DM / 64) * (NUP / 32), I_DN = (DFF / 64) * (DM / 32);
    constexpr int NITEMS = I_IN + I_GLU + 2 * I_BA + I_OUT + I_UP + I_DN;
    for (int it = gw; it < NITEMS; it += NGW) {
        int r = it;
        if (r < I_IN)  { transpose_item(ap->in[2] + (size_t)l * DM * NIN, DM, NIN, ap->in[1] + (size_t)l * DM, (bf16*)(ws + WS_WIN), scr, r, lane); continue; } r -= I_IN;
        if (r < I_GLU) { transpose_item(ap->in[18] + (size_t)l * DS * DS, DS, DS, nullptr, (bf16*)(ws + WS_WGLU), scr, r, lane); continue; } r -= I_GLU;
        if (r < I_BA)  { transpose_item(ap->in[20] + (size_t)l * DS * DM, DS, DM, nullptr, (bf16*)(ws + WS_WBA), scr, r, lane); continue; } r -= I_BA;
        if (r < I_BA)  { transpose_item(ap->in[21] + (size_t)l * DS * DM, DS, DM, nullptr, (bf16*)(ws + WS_WBS), scr, r, lane); continue; } r -= I_BA;
        if (r < I_OUT) { transpose_item(ap->in[22] + (size_t)l * DM * DM, DM, DM, nullptr, (bf16*)(ws + WS_WOUT), scr, r, lane); continue; } r -= I_OUT;
        if (r < I_UP)  { transpose_item(ap->in[24] + (size_t)l * DM * NUP, DM, NUP, ap->in[23] + (size_t)l * DM, (bf16*)(ws + WS_WUP), scr, r, lane); continue; } r -= I_UP;
        transpose_item(ap->in[27] + (size_t)l * DFF * DM, DFF, DM, nullptr, (bf16*)(ws + WS_WDN), scr, r, lane);
    }
}
__device__ __forceinline__ void ph_xprep(const float* src, float* cp, bf16* xb, float* rstd, int gw, int NGW, int lane) {
    for (int m = gw; m < MR; m += NGW) {
        const GAS f32x4* xr = (const GAS f32x4*)(src + (size_t)m * DM) + lane;
        f32x4 v[8]; float s = 0.f;
#pragma unroll
        for (int j = 0; j < 8; ++j) { v[j] = xr[64 * j]; s += (v[j].x * v[j].x + v[j].y * v[j].y) + (v[j].z * v[j].z + v[j].w * v[j].w); }
        s = wave_sum(s);
        if (lane == 0) rstd[m] = __builtin_amdgcn_rsqf(s * (1.0f / DM) + EPS);
        GAS unsigned long long* o8 = (GAS unsigned long long*)(xb + (size_t)m * DM) + lane;
#pragma unroll
        for (int j = 0; j < 8; ++j) o8[64 * j] = (unsigned long long)pk2(v[j].x, v[j].y) | ((unsigned long long)pk2(v[j].z, v[j].w) << 32);
        if (cp) { GAS f32x4* c4 = (GAS f32x4*)(cp + (size_t)m * DM) + lane;
#pragma unroll
            for (int j = 0; j < 8; ++j) c4[64 * j] = v[j]; }
    }
}
__device__ __forceinline__ void ph_qknorm(KArgsP ap, int l, int gw, int NGW, int lane) {
    bf16* PROJ = (bf16*)(ap->ws + WS_PROJ);
    const int gi = lane & 31;
    const float* g = (gi < 16 ? ap->in[3] : ap->in[4]) + l * 64;
    for (int it = gw; it < MR / 2; it += NGW) {
        const int row = 2 * it + (lane >> 5);
        GAS v4u* p = (GAS v4u*)(PROJ + (size_t)row * NIN + gi * 64);
        v4u w[8]; float ss = 0.f;
#pragma unroll
        for (int j = 0; j < 8; ++j) { w[j] = p[j];
            const float f0 = bf_lo(w[j].x), f1 = bf_hi(w[j].x), f2 = bf_lo(w[j].y), f3 = bf_hi(w[j].y), f4 = bf_lo(w[j].z), f5 = bf_hi(w[j].z), f6 = bf_lo(w[j].w), f7 = bf_hi(w[j].w);
            ss += (f0 * f0 + f1 * f1) + (f2 * f2 + f3 * f3) + (f4 * f4 + f5 * f5) + (f6 * f6 + f7 * f7); }
        const float sc = __builtin_amdgcn_rsqf(ss * (1.0f / 64.0f) + EPS) * (gi < 16 ? QSCALE : 1.0f);
#pragma unroll
        for (int j = 0; j < 8; ++j) { const f32x4 g0 = *(const f32x4*)(g + 8 * j), g1 = *(const f32x4*)(g + 8 * j + 4); v4u o;
            o.x = pk2(bf_lo(w[j].x) * sc * g0.x, bf_hi(w[j].x) * sc * g0.y); o.y = pk2(bf_lo(w[j].y) * sc * g0.z, bf_hi(w[j].y) * sc * g0.w);
            o.z = pk2(bf_lo(w[j].z) * sc * g1.x, bf_hi(w[j].z) * sc * g1.y); o.w = pk2(bf_lo(w[j].w) * sc * g1.z, bf_hi(w[j].w) * sc * g1.w);
            p[j] = o; }
    }
}
__device__ __forceinline__ void ph_ssm_naive(KArgsP ap, int l, int vcu, int G, int wave, int lane) {
    const bf16* PROJ = (const bf16*)(ap->ws + WS_PROJ); bf16* YG = (bf16*)(ap->ws + WS_YG);
    const float* are = ap->in[10] + (size_t)l * NG * NPS; const float* aim = ap->in[11] + (size_t)l * NG * NPS; const float* ldt = ap->in[12] + (size_t)l * NG;
    const float* bre = ap->in[13] + (size_t)l * NG * NPS * NIS; const float* bim = ap->in[14] + (size_t)l * NG * NPS * NIS;
    const float* cre = ap->in[15] + (size_t)l * NG * NIS * NPS; const float* cim = ap->in[16] + (size_t)l * NG * NIS * NPS; const float* dsk = ap->in[17] + (size_t)l * DS;
    for (int u = wave * G + vcu; u < NB * NG; u += NWAVES * G) {
        const int b = u / NG, g = u % NG, p = lane;
        const float dt = __builtin_amdgcn_exp2f(ldt[g] * LOG2E), ar = are[g * NPS + p], ai = aim[g * NPS + p];
        const float mag = __builtin_amdgcn_exp2f(dt * ar * LOG2E), ph_ = dt * ai * 0.15915494309189535f, abr = mag * __builtin_amdgcn_cosf(ph_), abi = mag * __builtin_amdgcn_sinf(ph_);
        const float iden = __builtin_amdgcn_rcpf(ar * ar + ai * ai), zr = abr - 1.0f, zi = abi, fre = (zr * ar + zi * ai) * iden, fim = (zi * ar - zr * ai) * iden;
        float Br[16], Bi[16], Cr[16], Ci[16];
#pragma unroll
        for (int i = 0; i < 16; ++i) { const float br = bre[(size_t)(g * NPS + p) * NIS + i], bi = bim[(size_t)(g * NPS + p) * NIS + i]; Br[i] = fre * br - fim * bi; Bi[i] = fre * bi + fim * br;
            Cr[i] = cre[(size_t)(g * NIS + i) * NPS + p]; Ci[i] = cim[(size_t)(g * NIS + i) * NPS + p]; }
        const int o = ((lane >> 5) & 1) * 8 + ((lane >> 4) & 1) * 4 + ((lane >> 3) & 1) * 2 + ((lane >> 2) & 1);
        const float dko = dsk[g * NIS + o];
        const bool b32 = (lane & 32) != 0, b16 = (lane & 16) != 0, b8 = (lane & 8) != 0, b4 = (lane & 4) != 0;
        const bf16* up = PROJ + (size_t)(b * SEQ) * NIN + OFF_U + g * NIS;
        bf16* yp = YG + (size_t)(b * SEQ) * DS + g * NIS + o;
        float hr = 0.f, hi = 0.f;
        v4u w0 = *(const GAS v4u*)(up), w1 = *(const GAS v4u*)(up + 8);
        for (int t = 0; t < SEQ; ++t) {
            const v4u c0 = w0, c1 = w1;
            const float uo = bf_lo((unsigned)up[(size_t)t * NIN + o]);
            if (t + 1 < SEQ) { w0 = *(const GAS v4u*)(up + (size_t)(t + 1) * NIN); w1 = *(const GAS v4u*)(up + (size_t)(t + 1) * NIN + 8); }
            float uu[16];
            uu[0] = bf_lo(c0.x); uu[1] = bf_hi(c0.x); uu[2] = bf_lo(c0.y); uu[3] = bf_hi(c0.y); uu[4] = bf_lo(c0.z); uu[5] = bf_hi(c0.z); uu[6] = bf_lo(c0.w); uu[7] = bf_hi(c0.w);
            uu[8] = bf_lo(c1.x); uu[9] = bf_hi(c1.x); uu[10] = bf_lo(c1.y); uu[11] = bf_hi(c1.y); uu[12] = bf_lo(c1.z); uu[13] = bf_hi(c1.z); uu[14] = bf_lo(c1.w); uu[15] = bf_hi(c1.w);
            float xr = 0.f, xi = 0.f;
#pragma unroll
            for (int i = 0; i < 16; ++i) { xr += Br[i] * uu[i]; xi += Bi[i] * uu[i]; }
            const float nhr = abr * hr - abi * hi + xr, nhi = abr * hi + abi * hr + xi; hr = nhr; hi = nhi;
            float v8[8], v4[4], v2[2], v1;
#pragma unroll
            for (int i = 0; i < 8; ++i) { const float lo_ = Cr[i] * hr - Ci[i] * hi, hi_ = Cr[i + 8] * hr - Ci[i + 8] * hi; const float keep = b32 ? hi_ : lo_, send = b32 ? lo_ : hi_; v8[i] = keep + __shfl_xor(send, 32); }
#pragma unroll
            for (int i = 0; i < 4; ++i) { const float keep = b16 ? v8[i + 4] : v8[i], send = b16 ? v8[i] : v8[i + 4]; v4[i] = keep + __shfl_xor(send, 16); }
#pragma unroll
            for (int i = 0; i < 2; ++i) { const float keep = b8 ? v4[i + 2] : v4[i], send = b8 ? v4[i] : v4[i + 2]; v2[i] = keep + __shfl_xor(send, 8); }
            { const float keep = b4 ? v2[1] : v2[0], send = b4 ? v2[0] : v2[1]; v1 = keep + __shfl_xor(send, 4); }
            v1 += __shfl_xor(v1, 2); v1 += __shfl_xor(v1, 1);
            if ((lane & 3) == 0) yp[(size_t)t * DS] = (bf16)f2bf(gelu_t(v1 + dko * uo));
        }
    }
}
__device__ __forceinline__ void ph_attn_naive(KArgsP ap, LAS unsigned char* lds, int l, int vcu, int G, int tid, int wave, int lane) {
    const bf16* PROJ = (const bf16*)(ap->ws + WS_PROJ); bf16* ON = (bf16*)(ap->ws + WS_ON);
    LAS float* Kt = (LAS float*)lds; LAS float* Vt = Kt + 64 * 128;
    const int c = wave >> 2, r = 16 * (wave & 3) + (lane >> 2), s = lane & 3;
    float s1 = 0.f, s2 = 0.f;
    for (int d = 0; d < 64; ++d) { s1 += ap->in[5][l * 64 + d] * ap->in[6][l * 64 + d]; s2 += ap->in[7][l * 64 + d] * ap->in[8][l * 64 + d]; }
    const float lam_init = 0.8f - 0.6f * __builtin_amdgcn_exp2f(-0.3f * LOG2E * (float)l), lam = __builtin_amdgcn_exp2f(s1 * LOG2E) - __builtin_amdgcn_exp2f(s2 * LOG2E) + lam_init;
    const float* sg = ap->in[9] + l * 128;
    for (int su = vcu; su < NB * NH * 16; su += G) {
        const int bh = su >> 4, pi = su & 15, b = bh >> 3, h = bh & 7;
        const float sl2 = __builtin_amdgcn_exp2f(-(float)(h + 1)) * LOG2E;
        for (int half = 0; half < 2; ++half) {
            const int j = half ? 31 - pi : pi;
            const size_t row = (size_t)b * SEQ + 64 * j + r;
            const int qpos = 64 * j + r;
            float q[16];
            { const GAS v4u* qp = (const GAS v4u*)(PROJ + row * NIN + h * 128 + c * 64 + 16 * s); const v4u w0 = qp[0], w1 = qp[1];
              q[0] = bf_lo(w0.x); q[1] = bf_hi(w0.x); q[2] = bf_lo(w0.y); q[3] = bf_hi(w0.y); q[4] = bf_lo(w0.z); q[5] = bf_hi(w0.z); q[6] = bf_lo(w0.w); q[7] = bf_hi(w0.w);
              q[8] = bf_lo(w1.x); q[9] = bf_hi(w1.x); q[10] = bf_lo(w1.y); q[11] = bf_hi(w1.y); q[12] = bf_lo(w1.z); q[13] = bf_hi(w1.z); q[14] = bf_lo(w1.w); q[15] = bf_hi(w1.w); }
            float mx = -INFINITY, lsum = 0.f, o[32];
#pragma unroll
            for (int i = 0; i < 32; ++i) o[i] = 0.f;
            for (int kt = 0; kt <= j; ++kt) {
                __syncthreads();
#pragma unroll
                for (int i = 0; i < 2; ++i) { const int id = tid + 512 * i, kk = id >> 4, ch = id & 15;
                    const bf16* src = PROJ + ((size_t)b * SEQ + 64 * kt + kk) * NIN + h * 128 + ch * 8;
                    const v4u kw = *(const GAS v4u*)(src + OFF_K), vw = *(const GAS v4u*)(src + OFF_V);
                    LAS f32x4* kd = (LAS f32x4*)(Kt + kk * 128 + ch * 8); LAS f32x4* vd = (LAS f32x4*)(Vt + kk * 128 + ch * 8);
                    kd[0] = (f32x4){bf_lo(kw.x), bf_hi(kw.x), bf_lo(kw.y), bf_hi(kw.y)}; kd[1] = (f32x4){bf_lo(kw.z), bf_hi(kw.z), bf_lo(kw.w), bf_hi(kw.w)};
                    vd[0] = (f32x4){bf_lo(vw.x), bf_hi(vw.x), bf_lo(vw.y), bf_hi(vw.y)}; vd[1] = (f32x4){bf_lo(vw.z), bf_hi(vw.z), bf_lo(vw.w), bf_hi(vw.w)}; }
                __syncthreads();
#pragma unroll 1
                for (int key = 0; key < 64; ++key) {
                    const LAS f32x4* kp = (const LAS f32x4*)(Kt + key * 128 + c * 64 + 16 * s);
                    const f32x4 k0 = kp[0], k1 = kp[1], k2 = kp[2], k3 = kp[3];
                    float d = (q[0] * k0.x + q[1] * k0.y + q[2] * k0.z + q[3] * k0.w) + (q[4] * k1.x + q[5] * k1.y + q[6] * k1.z + q[7] * k1.w)
                            + (q[8] * k2.x + q[9] * k2.y + q[10] * k2.z + q[11] * k2.w) + (q[12] * k3.x + q[13] * k3.y + q[14] * k3.z + q[15] * k3.w);
                    d += __shfl_xor(d, 1); d += __shfl_xor(d, 2);
                    const int dist = qpos - (64 * kt + key); const float sc = d - sl2 * (float)(dist < 0 ? -dist : dist);
                    const float mn = fmaxf(mx, sc), f = __builtin_amdgcn_exp2f(mx - mn), pr = __builtin_amdgcn_exp2f(sc - mn); mx = mn; lsum = lsum * f + pr;
                    const LAS f32x4* vp = (const LAS f32x4*)(Vt + key * 128 + 32 * s);
#pragma unroll
                    for (int i = 0; i < 8; ++i) { const f32x4 vv = vp[i]; o[4 * i] = o[4 * i] * f + pr * vv.x; o[4 * i + 1] = o[4 * i + 1] * f + pr * vv.y; o[4 * i + 2] = o[4 * i + 2] * f + pr * vv.z; o[4 * i + 3] = o[4 * i + 3] * f + pr * vv.w; }
                }
            }
            __syncthreads();
            const float il = __builtin_amdgcn_rcpf(lsum);
            if (c == 1) {
#pragma unroll
                for (int i = 0; i < 32; ++i) Kt[r * 128 + 32 * s + i] = o[i] * il; }
            __syncthreads();
            if (c == 0) { float ss = 0.f;
#pragma unroll
                for (int i = 0; i < 32; ++i) { o[i] = o[i] * il - lam * Kt[r * 128 + 32 * s + i]; ss += o[i] * o[i]; }
                ss += __shfl_xor(ss, 1); ss += __shfl_xor(ss, 2);
                const float sc = __builtin_amdgcn_rsqf(ss * (1.0f / 128.0f) + EPS) * (1.0f - lam_init);
                GAS v4u* op = (GAS v4u*)(ON + row * DS + h * 128 + 32 * s);
#pragma unroll
                for (int i = 0; i < 4; ++i) { v4u w; w.x = pk2(o[8 * i] * sc * sg[32 * s + 8 * i], o[8 * i + 1] * sc * sg[32 * s + 8 * i + 1]); w.y = pk2(o[8 * i + 2] * sc * sg[32 * s + 8 * i + 2], o[8 * i + 3] * sc * sg[32 * s + 8 * i + 3]);
                    w.z = pk2(o[8 * i + 4] * sc * sg[32 * s + 8 * i + 4], o[8 * i + 5] * sc * sg[32 * s + 8 * i + 5]); w.w = pk2(o[8 * i + 6] * sc * sg[32 * s + 8 * i + 6], o[8 * i + 7] * sc * sg[32 * s + 8 * i + 7]); op[i] = w; } }
        }
    }
    __syncthreads();
}
__device__ __forceinline__ void ph_conv_act(KArgsP ap, int l, long gtid, long NT) {
    const bf16* UP = (const bf16*)(ap->ws + WS_UP); bf16* Gb = (bf16*)(ap->ws + WS_G);
    const float* cw = ap->in[25] + (size_t)l * 3 * NUP; const float* cb = ap->in[26] + (size_t)l * NUP;
    constexpr int NF8 = DFF / 8; const long total = (long)MR * NF8;
    for (long it = gtid; it < total; it += NT) {
        const int row = (int)(it / NF8), f = (int)(it % NF8) * 8, t = row % SEQ;
        float av[8], vv[8];
        { const f32x4 b0 = *(const f32x4*)(cb + f), b1 = *(const f32x4*)(cb + f + 4), b2 = *(const f32x4*)(cb + DFF + f), b3 = *(const f32x4*)(cb + DFF + f + 4);
          av[0] = b0.x; av[1] = b0.y; av[2] = b0.z; av[3] = b0.w; av[4] = b1.x; av[5] = b1.y; av[6] = b1.z; av[7] = b1.w;
          vv[0] = b2.x; vv[1] = b2.y; vv[2] = b2.z; vv[3] = b2.w; vv[4] = b3.x; vv[5] = b3.y; vv[6] = b3.z; vv[7] = b3.w; }
#pragma unroll
        for (int jj = 0; jj < 3; ++jj) { if (t - 2 + jj < 0) continue;
            const bf16* up = UP + (size_t)(row - 2 + jj) * NUP + f;
            const v4u wa = *(const GAS v4u*)up, wv = *(const GAS v4u*)(up + DFF);
            const float* c0 = cw + (size_t)jj * NUP + f;
            const f32x4 ca0 = *(const f32x4*)c0, ca1 = *(const f32x4*)(c0 + 4), cv0 = *(const f32x4*)(c0 + DFF), cv1 = *(const f32x4*)(c0 + DFF + 4);
            av[0] += ca0.x * bf_lo(wa.x); av[1] += ca0.y * bf_hi(wa.x); av[2] += ca0.z * bf_lo(wa.y); av[3] += ca0.w * bf_hi(wa.y);
            av[4] += ca1.x * bf_lo(wa.z); av[5] += ca1.y * bf_hi(wa.z); av[6] += ca1.z * bf_lo(wa.w); av[7] += ca1.w * bf_hi(wa.w);
            vv[0] += cv0.x * bf_lo(wv.x); vv[1] += cv0.y * bf_hi(wv.x); vv[2] += cv0.z * bf_lo(wv.y); vv[3] += cv0.w * bf_hi(wv.y);
            vv[4] += cv1.x * bf_lo(wv.z); vv[5] += cv1.y * bf_hi(wv.z); vv[6] += cv1.z * bf_lo(wv.w); vv[7] += cv1.w * bf_hi(wv.w); }
        v4u o; o.x = pk2(gelu_t(av[0]) * vv[0], gelu_t(av[1]) * vv[1]); o.y = pk2(gelu_t(av[2]) * vv[2], gelu_t(av[3]) * vv[3]);
        o.z = pk2(gelu_t(av[4]) * vv[4], gelu_t(av[5]) * vv[5]); o.w = pk2(gelu_t(av[6]) * vv[6], gelu_t(av[7]) * vv[7]);
        *(GAS v4u*)(Gb + (size_t)row * DFF + f) = o;
    }
}
#ifndef PHMASK
#define PHMASK 0xFFF
#endif
#define PON(i) ((PHMASK >> (i)) & 1)
#ifndef MK_PER_PHASE
#define MK_PER_PHASE 0
#endif
#define PH_LOCALS \
    KArgsP ap = fresh_args(); \
    int tid = threadIdx.x; asm volatile("" : "+v"(tid)); \
    const int lane = tid & 63, wave = __builtin_amdgcn_readfirstlane(tid >> 6); \
    int G = gridDim.x, bx = blockIdx.x; asm volatile("" : "+s"(G), "+s"(bx)); \
    const int vcu = (G % 8 == 0) ? (bx % 8) * (G / 8) + bx / 8 : bx, gw = vcu * NWAVES + wave, NGW = G * NWAVES; \
    unsigned char* const ws = ap->ws; (void)lane; (void)gw; (void)NGW; (void)ws; (void)vcu
__global__ void __launch_bounds__(NTHR, 2) fwd_kernel(Args a) {
    extern __shared__ __attribute__((aligned(16))) unsigned char lds_raw[];
    LAS unsigned char* lds = (LAS unsigned char*)lds_raw;
    for (int u = threadIdx.x; u < (LDS_BYTES - LDSCTL_OFF) / 4; u += NTHR) ((LAS unsigned*)(lds + LDSCTL_OFF))[u] = 0u;
    __syncthreads();
    (void)xcd_barrier_post((unsigned*)(fresh_args()->ws + WS_CTL) + CW_BAR, (volatile LAS unsigned*)(lds + MISC_OFF) + 8);
    const int lo = a.ph_lo, hi = a.ph_hi;
#define IN(k) (lo <= (k) && (k) < hi)
#define SEAM(k) do { if (IN(k) && IN((k) + 1)) { XcdBarrier b_; b_.bar = (unsigned*)(fresh_args()->ws + WS_CTL) + CW_BAR; b_.x = xb_xcc_id(); b_.st = (volatile LAS unsigned*)(lds + MISC_OFF) + 8; xcd_barrier(b_); } } while (0)
#define GEMM_PHASE(EpiT, Eobj, Aptr, Bptr, Nv, Kv) do { pg8::Gemm g_{(const pg8::bf16_t*)(Aptr), (const pg8::bf16_t*)(Bptr), MR, (Nv), (Kv)}; pg8::StaticOrder S_; S_.init(MR, (Nv), G, bx); \
        pg8::gemm_phase<EpiT, pg8::StaticOrder, true, true>(lds, g_, S_, Eobj); } while (0)
#define WSP(T, off) ((T*)(ws + (off)))

    if (IN(0) && PON(0)) { PH_LOCALS; ph_convert(ap, lds, 0, gw, NGW, wave, lane); ph_xprep(ap->in[0], ap->out, WSP(bf16, WS_XB), WSP(float, WS_RSTD), gw, NGW, lane); }
    SEAM(0);
    for (int l = 0; l < NL; ++l) {
        const int p0 = 1 + PH_PER_LAYER * l;
        if (IN(p0 + 0) && PON(1)) { PH_LOCALS; pg8::EpiScaleBf16 E{WSP(bf16, WS_PROJ), NIN, WSP(float, WS_RSTD)}; GEMM_PHASE(pg8::EpiScaleBf16, E, ws + WS_XB, ws + WS_WIN, NIN, DM); }
        SEAM(p0 + 0);
        if (IN(p0 + 1) && PON(2)) { PH_LOCALS; ph_qknorm(ap, l, gw, NGW, lane); ph_ssm_naive(ap, l, vcu, G, wave, lane); }
        SEAM(p0 + 1);
        if (IN(p0 + 2) && PON(3)) { PH_LOCALS;
#ifndef NO_GLU
            { pg8::EpiGlu E{WSP(bf16, WS_Y2), WSP(bf16, WS_YG), DS, ap->in[19] + (size_t)l * DS}; GEMM_PHASE(pg8::EpiGlu, E, ws + WS_YG, ws + WS_WGLU, DS, DS); }
#endif
#ifndef NO_ATTN
            ph_attn_naive(ap, lds, l, vcu, G, tid, wave, lane);
#endif
        }
        SEAM(p0 + 2);
        if (IN(p0 + 3) && PON(4)) { PH_LOCALS; pg8::EpiGate1 E{WSP(float, WS_PROJ), 4096, WSP(bf16, WS_PROJ) + OFF_GA, NIN}; GEMM_PHASE(pg8::EpiGate1, E, ws + WS_ON, ws + WS_WBA, DM, DS); }
        SEAM(p0 + 3);
        if (IN(p0 + 4) && PON(5)) { PH_LOCALS; pg8::EpiGate2 E{WSP(bf16, WS_MIX), DM, WSP(float, WS_PROJ), 4096, WSP(bf16, WS_PROJ) + OFF_GS, NIN}; GEMM_PHASE(pg8::EpiGate2, E, ws + WS_Y2, ws + WS_WBS, DM, DS); }
        SEAM(p0 + 4);
        if (IN(p0 + 5) && PON(6)) { PH_LOCALS; pg8::EpiResid E{ap->out, DM}; GEMM_PHASE(pg8::EpiResid, E, ws + WS_MIX, ws + WS_WOUT, DM, DM); }
        SEAM(p0 + 5);
        if (IN(p0 + 6) && PON(7)) { PH_LOCALS; ph_xprep(ap->out, nullptr, WSP(bf16, WS_XB), WSP(float, WS_RSTD), gw, NGW, lane); }
        SEAM(p0 + 6);
        if (IN(p0 + 7) && PON(8)) { PH_LOCALS; pg8::EpiScaleBf16 E{WSP(bf16, WS_UP), NUP, WSP(float, WS_RSTD)}; GEMM_PHASE(pg8::EpiScaleBf16, E, ws + WS_XB, ws + WS_WUP, NUP, DM); }
        SEAM(p0 + 7);
        if (IN(p0 + 8) && PON(9)) { PH_LOCALS; ph_conv_act(ap, l, (long)vcu * NTHR + tid, (long)G * NTHR); }
        SEAM(p0 + 8);
        if (IN(p0 + 9) && PON(10)) { PH_LOCALS; pg8::EpiResid E{ap->out, DM}; GEMM_PHASE(pg8::EpiResid, E, ws + WS_G, ws + WS_WDN, DM, DFF); }
        SEAM(p0 + 9);
        if (IN(p0 + 10) && PON(11) && l + 1 < NL) { PH_LOCALS; ph_convert(ap, lds, l + 1, gw, NGW, wave, lane); ph_xprep(ap->out, nullptr, WSP(bf16, WS_XB), WSP(float, WS_RSTD), gw, NGW, lane); }
        SEAM(p0 + 10);
    }
#undef IN
#undef SEAM
#undef GEMM_PHASE
}

extern "C" void kernel_launch(void* const* d_in, const int* in_sizes, int n_in, void* d_out, int out_size, void* d_ws, size_t ws_size, hipStream_t stream) {
    static int grid = 0;
    if (grid == 0) {
        if (n_in != 28 || in_sizes[0] != MR * DM || out_size != MR * DM || ws_size < WS_END) { fprintf(stderr, "kernel_launch: unexpected shapes / workspace (n_in %d, ws %zu, need %zu); nothing launched\n", n_in, ws_size, (size_t)WS_END); grid = -1; return; }
        int dev = 0, cus = 0, per_cu = 0;
        if (hipGetDevice(&dev) != hipSuccess || hipDeviceGetAttribute(&cus, hipDeviceAttributeMultiprocessorCount, dev) != hipSuccess) { grid = -1; return; }
        if (hipFuncSetAttribute((const void*)fwd_kernel, hipFuncAttributeMaxDynamicSharedMemorySize, LDS_BYTES) != hipSuccess) { fprintf(stderr, "kernel_launch: hipFuncSetAttribute failed\n"); grid = -1; return; }
        if (hipOccupancyMaxActiveBlocksPerMultiprocessor(&per_cu, (const void*)fwd_kernel, NTHR, LDS_BYTES) != hipSuccess || per_cu < 1) { fprintf(stderr, "kernel_launch: occupancy query says %d\n", per_cu); }
        (void)hipGetLastError();
        grid = cus;
    }
    if (grid < 0) return;
    if (hipMemsetAsync((char*)d_ws + WS_CTL, 0, CTL_ZERO_BYTES, stream) != hipSuccess) return;
    Args a{};
    for (int i = 0; i < 28; ++i) a.in[i] = (const float*)d_in[i];
    a.out = (float*)d_out; a.ws = (unsigned char*)d_ws;
#if MK_PER_PHASE
    for (int ph = 0; ph < N_PHASES - 1; ++ph) { a.ph_lo = ph; a.ph_hi = ph + 1; hipLaunchKernelGGL(fwd_kernel, dim3(grid), dim3(NTHR), LDS_BYTES, stream, a); }
#else
    a.ph_lo = 0; a.ph_hi = N_PHASES;
    hipLaunchKernelGGL(fwd_kernel, dim3(grid), dim3(NTHR), LDS_BYTES, stream, a);
#endif
    const hipError_t le = hipPeekAtLastError();
    if (le != hipSuccess) fprintf(stderr, "kernel_launch: launch failed: %s\n", hipGetErrorName(le));
}
```

```cpp
#include <hip/hip_runtime.h>
#include <cstdio>
#include <cstdint>
namespace pg8 {
#define PG8_LAS __attribute__((address_space(3)))
typedef unsigned short bf16_t;
typedef short bf16x8 __attribute__((ext_vector_type(8)));
typedef float f32x4 __attribute__((ext_vector_type(4)));
typedef unsigned u32x4 __attribute__((ext_vector_type(4)));
constexpr int BM = 256, BK = 64, HALF = 128, HTB = HALF * BK * 2  , STAGE_BYTES = 8 * HTB, NXCD = 8, WGM = 8;

__host__ __device__ __forceinline__ int lds_byte(int r, int c) { const int st = (r >> 4) * 2 + (c >> 5), rr = r & 15, cc = c & 31, ob = rr * 64 + cc * 2; return st * 1024 + (ob ^ (((ob >> 9) & 1) << 5)); }
__host__ __device__ __forceinline__ void stage_rc(int b, int& R, int& C) { const int st = b / 1024, sb = b % 1024, swz = sb ^ (((sb >> 9) & 1) << 5); R = (st >> 1) * 16 + swz / 64; C = (st & 1) * 32 + (swz % 64) / 2; }
__host__ __device__ __forceinline__ int perm32(int rho) { const int n = rho >> 4, i = rho & 15; return 8 * (i >> 2) + 4 * n + (i & 3); }

struct Unit { int pm, pn, seg; };
struct Gemm { const bf16_t* A; const bf16_t* Bt; int M, N, K, lda, ldb; const bf16_t* A2; const bf16_t* Bt2; };

struct StaticOrder {
    int nM, nN, nwg, G, c;
    __host__ __device__ void init(int M, int N, int G_, int c_) { nM = M / BM; nN = N / BM; nwg = nM * nN; G = G_; c = c_; }
    __host__ __device__ bool next(int i, Unit& u) const {
        const long L = (long)i * G + c; if (L >= nwg) return false;
        int wgid = (int)L; { const int q = nwg / NXCD, r = nwg % NXCD, xcd = wgid % NXCD, off = wgid / NXCD; wgid = (xcd < r ? xcd * (q + 1) : r * (q + 1) + (xcd - r) * q) + off; }
        const int nig = WGM * nN, gid = wgid / nig, fm = gid * WGM, gsz = (nM - fm) < WGM ? (nM - fm) : WGM;
        u.pm = fm + ((wgid % nig) % gsz); u.pn = (wgid % nig) / gsz; u.seg = 0; return true;
    }
    __device__ __forceinline__ void a_ready(const Unit&) const {}
    __device__ __forceinline__ void done(const Unit&) const {}
};

__device__ __forceinline__ unsigned cvt_pk_bf16(float lo, float hi) { unsigned r; asm volatile("v_cvt_pk_bf16_f32 %0, %1, %2" : "=v"(r) : "v"(lo), "v"(hi)); return r; }
typedef float f32x2 __attribute__((ext_vector_type(2)));
__device__ __forceinline__ f32x2 gelu_pk(f32x2 v) {
    const f32x2 av = __builtin_elementwise_abs(v), d = av * 0.2316418882f + 1.0f;
    f32x2 t; t.x = __builtin_amdgcn_rcpf(d.x); t.y = __builtin_amdgcn_rcpf(d.y);
    f32x2 q = t * 0.5307027145f + (-0.7265760135f); q = q * t + 0.7107068705f; q = q * t + (-0.142248368f); q = q * t + 0.127414796f; q = q * t;
    const f32x2 s = (v * v) * (-0.72134752044f);
    f32x2 e; e.x = __builtin_amdgcn_exp2f(s.x); e.y = __builtin_amdgcn_exp2f(s.y);
    const f32x2 m = v * (q * e), r = v - m;
    f32x2 o; o.x = v.x < 0.f ? m.x : r.x; o.y = v.y < 0.f ? m.y : r.y; return o;
}

__device__ __forceinline__ float bf_lo(unsigned w) { return __uint_as_float(w << 16); }
__device__ __forceinline__ float bf_hi(unsigned w) { return __uint_as_float(w & 0xffff0000u); }
__device__ __forceinline__ float sigm(float z) { return __builtin_amdgcn_rcpf(1.0f + __builtin_amdgcn_exp2f(-1.4426950408889634f * z)); }
__device__ __forceinline__ f32x4 gelu_mul4(f32x4 x, f32x4 v) {
    const f32x4 t = x * x, w = t * (-2.302208198f * 0.044715f) + (-2.302208198f), z = x * w;
    f32x4 e; e[0] = __builtin_amdgcn_exp2f(z[0]); e[1] = __builtin_amdgcn_exp2f(z[1]); e[2] = __builtin_amdgcn_exp2f(z[2]); e[3] = __builtin_amdgcn_exp2f(z[3]);
    const f32x4 d = e + 1.0f; f32x4 r; r[0] = __builtin_amdgcn_rcpf(d[0]); r[1] = __builtin_amdgcn_rcpf(d[1]); r[2] = __builtin_amdgcn_rcpf(d[2]); r[3] = __builtin_amdgcn_rcpf(d[3]);
    return (x * v) * r;
}
__device__ __forceinline__ float gelu_t(float x) { const float u = x * (1.0f + 0.044715f * x * x); return x * __builtin_amdgcn_rcpf(1.0f + __builtin_amdgcn_exp2f(-2.302208198f * u)); }

__device__ __forceinline__ float sum_fq4(float v) {
    { auto r = __builtin_amdgcn_permlane16_swap(__float_as_uint(v), __float_as_uint(v), false, false); v = __uint_as_float(r[0]) + __uint_as_float(r[1]); }
    { auto r = __builtin_amdgcn_permlane32_swap(__float_as_uint(v), __float_as_uint(v), false, false); v = __uint_as_float(r[0]) + __uint_as_float(r[1]); }
    return v;
}
__device__ __forceinline__ float row_rstd(const float* ssq, int row, int fq) {
    const f32x4 a = *(const f32x4*)(ssq + (size_t)row * 32 + 8 * fq), b = *(const f32x4*)(ssq + (size_t)row * 32 + 8 * fq + 4);
    float s = ((a[0] + a[1]) + (a[2] + a[3])) + ((b[0] + b[1]) + (b[2] + b[3]));
    s = sum_fq4(s);
    return __builtin_amdgcn_rsqf(s * (1.0f / 2048.0f) + 1e-6f);
}
struct RstdTab { const PG8_LAS float* tab; int p0, p1, p2, p3; const float* ssq;
    __device__ __forceinline__ const PG8_LAS float* base(int pm) const { return (pm == p0) ? tab : (pm == p1) ? tab + 256 : (pm == p2) ? tab + 512 : (pm == p3) ? tab + 768 : (const PG8_LAS float*)nullptr; }
    __device__ __forceinline__ float get(const PG8_LAS float* tb, int row, int fq) const { return tb ? tb[row & 255] : row_rstd(ssq, row, fq); }
};
struct EpiGlu { static constexpr bool PERM = true, AFTER_DRAIN = false, ROWMAP = false, TWOSEG = false;
    bf16_t* O; const bf16_t* Y; int ld; const float* bias;
    __device__ __forceinline__ void operator()(const f32x4 (&acc)[2][2][4][2], const Unit& u, int wr, int wc, int fr, int fq) const {
        const int row0 = u.pm * BM + wr * 64 + fr, col0 = u.pn * BM + wc * 32 + 8 * fq;
        f32x4 bv[2][2];
#pragma unroll
        for (int bj = 0; bj < 2; ++bj)
#pragma unroll
            for (int n = 0; n < 2; ++n) bv[bj][n] = *(const f32x4*)(bias + col0 + bj * HALF + 4 * n);
#pragma unroll
        for (int ai = 0; ai < 2; ++ai) {
            u32x4 yv[4][2];
#pragma unroll
            for (int m = 0; m < 4; ++m)
#pragma unroll
                for (int bj = 0; bj < 2; ++bj) yv[m][bj] = *(const u32x4*)(Y + (size_t)(row0 + ai * HALF + m * 16) * ld + col0 + bj * HALF);
            asm volatile("" ::: "memory");
#pragma unroll
            for (int m = 0; m < 4; ++m) { const size_t off = (size_t)(row0 + ai * HALF + m * 16) * ld + col0;
#pragma unroll
                for (int bj = 0; bj < 2; ++bj) { const f32x4 z0 = acc[ai][bj][m][0] + bv[bj][0], z1 = acc[ai][bj][m][1] + bv[bj][1];
                    const u32x4 y = yv[m][bj];
                    u32x4 w; w.x = cvt_pk_bf16(bf_lo(y.x) * sigm(z0[0]), bf_hi(y.x) * sigm(z0[1])); w.y = cvt_pk_bf16(bf_lo(y.y) * sigm(z0[2]), bf_hi(y.y) * sigm(z0[3]));
                    w.z = cvt_pk_bf16(bf_lo(y.z) * sigm(z1[0]), bf_hi(y.z) * sigm(z1[1])); w.w = cvt_pk_bf16(bf_lo(y.w) * sigm(z1[2]), bf_hi(y.w) * sigm(z1[3]));
                    *(u32x4*)(O + off + bj * HALF) = w; } }
            asm volatile("" ::: "memory");
        }
    }
};
struct EpiResid { static constexpr bool PERM = true, AFTER_DRAIN = false, ROWMAP = false, TWOSEG = false;
    bf16_t* XB; float* ssq; float* OUT;
    __device__ __forceinline__ void operator()(const f32x4 (&acc)[2][2][4][2], const Unit& u, int wr, int wc, int fr, int fq) const {
        const int row0 = u.pm * BM + wr * 64 + fr, col0 = u.pn * BM + wc * 32 + 8 * fq;
#pragma unroll
        for (int ai = 0; ai < 2; ++ai)
#pragma unroll
        for (int mh = 0; mh < 2; ++mh) {
            u32x4 hv[2][2];
#pragma unroll
            for (int m2 = 0; m2 < 2; ++m2)
#pragma unroll
                for (int bj = 0; bj < 2; ++bj) { const size_t off = (size_t)(row0 + ai * HALF + (2 * mh + m2) * 16) * 2048 + col0 + bj * HALF; hv[m2][bj] = *(const u32x4*)(XB + off); }
            asm volatile("" ::: "memory");
            float ssv[2];
#pragma unroll
            for (int m2 = 0; m2 < 2; ++m2) { const int m = 2 * mh + m2, row = row0 + ai * HALF + m * 16; float ss = 0.f;
#pragma unroll
                for (int bj = 0; bj < 2; ++bj) { const size_t off = (size_t)row * 2048 + col0 + bj * HALF; const u32x4 h = hv[m2][bj];
                    const f32x4 x0 = (f32x4){bf_lo(h.x), bf_hi(h.x), bf_lo(h.y), bf_hi(h.y)} + acc[ai][bj][m][0];
                    const f32x4 x1 = (f32x4){bf_lo(h.z), bf_hi(h.z), bf_lo(h.w), bf_hi(h.w)} + acc[ai][bj][m][1];
                    ss += ((x0[0] * x0[0] + x0[1] * x0[1]) + (x0[2] * x0[2] + x0[3] * x0[3])) + ((x1[0] * x1[0] + x1[1] * x1[1]) + (x1[2] * x1[2] + x1[3] * x1[3]));
                    if (OUT) { *(f32x4*)(OUT + off) = x0; *(f32x4*)(OUT + off + 4) = x1; }
                    else { u32x4 w; w.x = cvt_pk_bf16(x0[0], x0[1]); w.y = cvt_pk_bf16(x0[2], x0[3]); w.z = cvt_pk_bf16(x1[0], x1[1]); w.w = cvt_pk_bf16(x1[2], x1[3]);
                        *(u32x4*)(XB + off) = w; } }
                ssv[m2] = ss; }
#pragma unroll
            for (int m2 = 0; m2 < 2; ++m2) { float ss = sum_fq4(ssv[m2]);
                if (fq == 0) ssq[(size_t)(row0 + ai * HALF + (2 * mh + m2) * 16) * 32 + 4 * u.pn + wc] = ss; }
            asm volatile("" ::: "memory");
        }
    }
};
struct GroupOrder {
    int nwg, G, c, per;
    __device__ __forceinline__ bool next(int i, Unit& u) const { const long L = (long)i * G + c; if (L >= nwg) return false; u.pm = (int)L; u.pn = (int)L / per; u.seg = 0; return true; }
    __device__ __forceinline__ void a_ready(const Unit&) const {}
    __device__ __forceinline__ void done(const Unit&) const {}
};
struct EpiSsmS { static constexpr bool PERM = true, AFTER_DRAIN = false, ROWMAP = false, TWOSEG = false;
    bf16_t* S;
    __device__ __forceinline__ void operator()(const f32x4 (&acc)[2][2][4][2], const Unit& u, int wr, int wc, int fr, int fq) const {
        const int row0 = u.pm * BM + wr * 64 + fr, col0 = wc * 32 + 8 * fq;
#pragma unroll
        for (int ai = 0; ai < 2; ++ai)
#pragma unroll
            for (int m = 0; m < 4; ++m) { const f32x4 a0 = acc[ai][0][m][0], a1 = acc[ai][0][m][1];
                u32x4 w; w.x = cvt_pk_bf16(a0[0], a0[1]); w.y = cvt_pk_bf16(a0[2], a0[3]); w.z = cvt_pk_bf16(a1[0], a1[1]); w.w = cvt_pk_bf16(a1[2], a1[3]);
                *(u32x4*)(S + (size_t)(row0 + ai * HALF + m * 16) * 128 + col0) = w; }
    }
};
struct EpiSsmY { static constexpr bool PERM = true, AFTER_DRAIN = false, ROWMAP = false, TWOSEG = false;
    bf16_t* Y;
    __device__ __forceinline__ void operator()(const f32x4 (&acc)[2][2][4][2], const Unit& u, int wr, int wc, int fr, int fq) const {
        const int g = u.pn, row0 = u.pm * BM - g * 2048 + wr * 64 + fr, col0 = wc * 32 + 8 * fq;
#pragma unroll
        for (int ai = 0; ai < 2; ++ai)
#pragma unroll
            for (int m = 0; m < 4; ++m) { const int R = row0 + ai * HALF + m * 16;
#pragma unroll
                for (int bj = 0; bj < 2; ++bj) { const int col = col0 + bj * HALF, j = col >> 4, o8 = col & 8; const f32x4 a0 = acc[ai][bj][m][0], a1 = acc[ai][bj][m][1];
                    u32x4 w; w.x = cvt_pk_bf16(gelu_t(a0[0]), gelu_t(a0[1])); w.y = cvt_pk_bf16(gelu_t(a0[2]), gelu_t(a0[3])); w.z = cvt_pk_bf16(gelu_t(a1[0]), gelu_t(a1[1])); w.w = cvt_pk_bf16(gelu_t(a1[2]), gelu_t(a1[3]));
                    *(u32x4*)(Y + (size_t)(16 * R + j) * 1024 + 16 * g + o8) = w; } }
    }
};

__device__ __forceinline__ float dpp_shr1_z(float x) { return __builtin_bit_cast(float, __builtin_amdgcn_mov_dpp(__builtin_bit_cast(int, x), 0x111, 0xF, 0xF, true)); }
__device__ __forceinline__ float dpp_shr1_w(float x, float prevblk) { const int o = __builtin_amdgcn_mov_dpp(__builtin_bit_cast(int, prevblk), 0x121, 0xF, 0xF, true);
    return __builtin_bit_cast(float, __builtin_amdgcn_update_dpp(o, __builtin_bit_cast(int, x), 0x111, 0xF, 0xF, false)); }
struct EpiUpConv { static constexpr bool PERM = true, AFTER_DRAIN = false, ROWMAP = true, TWOSEG = false;
    bf16_t* Gm; bf16_t* RAW; RstdTab rt; const float* cw; const float* cb;
    __device__ __forceinline__ void operator()(const f32x4 (&acc)[2][2][4][2], const Unit& u, int wr, int wc, int fr, int fq) const {
        constexpr int DFF = 5504, NUP = 11008;
        const int tok0 = u.pm * BM + 128 * wr + 4 * fr, f0 = u.pn * 128 + wc * 32 + 8 * fq;
        const PG8_LAS float* tb_ = rt.base(u.pm);
        float rs[2][4];
#pragma unroll
        for (int ai = 0; ai < 2; ++ai)
#pragma unroll
            for (int m = 0; m < 4; ++m) rs[ai][m] = rt.get(tb_, tok0 + 64 * ai + m, fq);
        typedef unsigned u32x2g __attribute__((ext_vector_type(2))); u32x2g gst[2][4];
#pragma unroll
        for (int n = 0; n < 2; ++n) {
            const int f = f0 + 4 * n;
            const f32x4 w0a = *(const f32x4*)(cw + f), w1a = *(const f32x4*)(cw + NUP + f), w2a = *(const f32x4*)(cw + 2 * NUP + f), cba = *(const f32x4*)(cb + f);
            const f32x4 w0v = *(const f32x4*)(cw + DFF + f), w1v = *(const f32x4*)(cw + NUP + DFF + f), w2v = *(const f32x4*)(cw + 2 * NUP + DFF + f), cbv = *(const f32x4*)(cb + DFF + f);
            f32x4 pa2 = {0.f, 0.f, 0.f, 0.f}, pa3 = pa2, pv2 = pa2, pv3 = pa2;
#pragma unroll
            for (int ai = 0; ai < 2; ++ai) {
                f32x4 pa[4], pv[4];
#pragma unroll
                for (int m = 0; m < 4; ++m) { pa[m] = acc[ai][0][m][n] * rs[ai][m]; pv[m] = acc[ai][1][m][n] * rs[ai][m]; }
                f32x4 x1a, x2a, x1v, x2v;
#pragma unroll
                for (int e = 0; e < 4; ++e) {
                    if (ai == 0) { x1a[e] = dpp_shr1_z(pa[3][e]); x2a[e] = dpp_shr1_z(pa[2][e]); x1v[e] = dpp_shr1_z(pv[3][e]); x2v[e] = dpp_shr1_z(pv[2][e]); }
                    else { x1a[e] = dpp_shr1_w(pa[3][e], pa3[e]); x2a[e] = dpp_shr1_w(pa[2][e], pa2[e]); x1v[e] = dpp_shr1_w(pv[3][e], pv3[e]); x2v[e] = dpp_shr1_w(pv[2][e], pv2[e]); } }
                { const bool first = (ai == 0) && (fr == 0), last = (ai == 1) && (fr == 15);
                  if (first || last) { bf16_t* rp = RAW + ((size_t)u.pm * 8 + 4 * wr + 2 * ai) * NUP + f;
                      const f32x4 a0 = first ? pa[0] : pa[2], a1 = first ? pa[1] : pa[3], v0 = first ? pv[0] : pv[2], v1 = first ? pv[1] : pv[3];
                      typedef unsigned u32x2 __attribute__((ext_vector_type(2)));
                      u32x2 t; t.x = cvt_pk_bf16(a0[0], a0[1]); t.y = cvt_pk_bf16(a0[2], a0[3]); *(u32x2*)(rp) = t;
                      t.x = cvt_pk_bf16(a1[0], a1[1]); t.y = cvt_pk_bf16(a1[2], a1[3]); *(u32x2*)(rp + NUP) = t;
                      t.x = cvt_pk_bf16(v0[0], v0[1]); t.y = cvt_pk_bf16(v0[2], v0[3]); *(u32x2*)(rp + DFF) = t;
                      t.x = cvt_pk_bf16(v1[0], v1[1]); t.y = cvt_pk_bf16(v1[2], v1[3]); *(u32x2*)(rp + NUP + DFF) = t; } }
#pragma unroll
                for (int m = 0; m < 4; ++m) {
                    const f32x4 s1a = (m == 0) ? x1a : pa[m - 1], s2a = (m == 0) ? x2a : (m == 1) ? x1a : pa[m - 2];
                    const f32x4 s1v = (m == 0) ? x1v : pv[m - 1], s2v = (m == 0) ? x2v : (m == 1) ? x1v : pv[m - 2];
                    const f32x4 ca = cba + w0a * s2a + w1a * s1a + w2a * pa[m], cv = cbv + w0v * s2v + w1v * s1v + w2v * pv[m];
                    typedef unsigned u32x2 __attribute__((ext_vector_type(2)));
                    const f32x4 gv_ = gelu_mul4(ca, cv); u32x2 t; t.x = cvt_pk_bf16(gv_[0], gv_[1]); t.y = cvt_pk_bf16(gv_[2], gv_[3]);
                    if (n == 0) gst[ai][m] = t;
                    else { u32x4 w4; w4.x = gst[ai][m].x; w4.y = gst[ai][m].y; w4.z = t.x; w4.w = t.y; *(u32x4*)(Gm + (size_t)(tok0 + 64 * ai + m) * DFF + f0) = w4; } }
                pa2 = pa[2]; pa3 = pa[3]; pv2 = pv[2]; pv3 = pv[3];
            }
        }
    }
};

struct EpiWin { static constexpr bool PERM = true, AFTER_DRAIN = false, ROWMAP = false, TWOSEG = false;
    bf16_t* O; bf16_t* UC; RstdTab rt; const float* qg; const float* kg; float qscale;
    __device__ __forceinline__ void operator()(const f32x4 (&acc)[2][2][4][2], const Unit& u, int wr, int wc, int fr, int fq) const {
        const int row0 = u.pm * BM + wr * 64 + fr; const PG8_LAS float* tb_ = rt.base(u.pm);
        if (u.pn < 8) {
            const float* g = (u.pn < 4) ? qg : kg; const float sc0 = (u.pn < 4) ? qscale : 1.0f;
            f32x4 gv[2][2];
#pragma unroll
            for (int bj = 0; bj < 2; ++bj)
#pragma unroll
                for (int n = 0; n < 2; ++n) gv[bj][n] = *(const f32x4*)(g + 32 * bj + 8 * fq + 4 * n) * sc0;
#pragma unroll
            for (int ai = 0; ai < 2; ++ai)
#pragma unroll
                for (int m = 0; m < 4; ++m) { const int row = row0 + ai * HALF + m * 16; const float rs = rt.get(tb_, row, fq);
                    float sa = 0.f;
#pragma unroll
                    for (int bj = 0; bj < 2; ++bj)
#pragma unroll
                        for (int n = 0; n < 2; ++n) { const f32x4 a = acc[ai][bj][m][n]; sa += (a[0] * a[0] + a[1] * a[1]) + (a[2] * a[2] + a[3] * a[3]); }
                    sa = sum_fq4(sa);
                    const float sc = rs * __builtin_amdgcn_rsqf(rs * rs * sa * (1.0f / 64.0f) + 1e-6f);
#pragma unroll
                    for (int bj = 0; bj < 2; ++bj) { const f32x4 v0 = acc[ai][bj][m][0] * sc * gv[bj][0], v1 = acc[ai][bj][m][1] * sc * gv[bj][1];
                        u32x4 w; w.x = cvt_pk_bf16(v0[0], v0[1]); w.y = cvt_pk_bf16(v0[2], v0[3]); w.z = cvt_pk_bf16(v1[0], v1[1]); w.w = cvt_pk_bf16(v1[2], v1[3]);
                        *(u32x4*)(O + (size_t)row * 8192 + u.pn * BM + 64 * wc + 32 * bj + 8 * fq) = w; } }
        } else if (u.pn >= 12 && u.pn < 16) {
#pragma unroll
            for (int ai = 0; ai < 2; ++ai)
#pragma unroll
                for (int m = 0; m < 4; ++m) { const int row = row0 + ai * HALF + m * 16; const float s = rt.get(tb_, row, fq);
#pragma unroll
                    for (int bj = 0; bj < 2; ++bj) { const f32x4 v0 = acc[ai][bj][m][0] * s, v1 = acc[ai][bj][m][1] * s;
                        u32x4 w; w.x = cvt_pk_bf16(v0[0], v0[1]); w.y = cvt_pk_bf16(v0[2], v0[3]); w.z = cvt_pk_bf16(v1[0], v1[1]); w.w = cvt_pk_bf16(v1[2], v1[3]);
                        const int c = (u.pn - 12) * BM + bj * HALF + wc * 32 + 8 * fq, g = c >> 4;
                        *(u32x4*)(UC + ((size_t)g * 2048 + (row >> 4)) * 384 + 16 * (row & 15) + (c & 15)) = w; } }
        } else if (u.pn >= 16) {
            const int c0 = (u.pn - 16) * HALF + wc * 32 + 8 * fq;
#pragma unroll
            for (int ai = 0; ai < 2; ++ai)
#pragma unroll
                for (int m = 0; m < 4; ++m) { const int row = row0 + ai * HALF + m * 16; const float s = -1.4426950408889634f * rt.get(tb_, row, fq);
                    unsigned qa[2] = {0u, 0u}, qs[2] = {0u, 0u};
#pragma unroll
                    for (int n = 0; n < 2; ++n)
#pragma unroll
                        for (int e = 0; e < 4; ++e) { const float ea = __builtin_amdgcn_exp2f(s * acc[ai][0][m][n][e]), es = __builtin_amdgcn_exp2f(s * acc[ai][1][m][n][e]);
                            const float va = __builtin_amdgcn_rcpf(1.0f + ea), vs = __builtin_amdgcn_rcpf(1.0f + es);
                            const unsigned ia = (unsigned)(va * 255.0f + 0.5f); unsigned is = (unsigned)(vs * 255.0f + 0.5f); is = is < 1u ? 1u : is;
                            qa[n] |= ia << (8 * e); qs[n] |= is << (8 * e); }
                    u32x4 w; w.x = qa[0]; w.y = qa[1]; w.z = qs[0]; w.w = qs[1];
                    *(u32x4*)((unsigned char*)(O + (size_t)row * 8192 + 4096) + (size_t)(c0 >> 3) * 16) = w; }
        } else {
            const int col0 = u.pn * BM + wc * 32 + 8 * fq;
#pragma unroll
            for (int ai = 0; ai < 2; ++ai)
#pragma unroll
                for (int m = 0; m < 4; ++m) { const int row = row0 + ai * HALF + m * 16; const float s = rt.get(tb_, row, fq); bf16_t* rowp = O + (size_t)row * 8192 + col0;
#pragma unroll
                    for (int bj = 0; bj < 2; ++bj) { const f32x4 v0 = acc[ai][bj][m][0] * s, v1 = acc[ai][bj][m][1] * s;
                        u32x4 w; w.x = cvt_pk_bf16(v0[0], v0[1]); w.y = cvt_pk_bf16(v0[2], v0[3]); w.z = cvt_pk_bf16(v1[0], v1[1]); w.w = cvt_pk_bf16(v1[2], v1[3]);
                        *(u32x4*)(rowp + bj * HALF) = w; } }
        }
    }
};


struct TwoSegOrder {
    StaticOrder base;
    __device__ __forceinline__ bool next(int i, Unit& u) const { if (!base.next(i >> 1, u)) return false; u.seg = i & 1; return true; }
    __device__ __forceinline__ void a_ready(const Unit&) const {}
    __device__ __forceinline__ void done(const Unit&) const {}
};
__device__ __forceinline__ f32x4 ub4(unsigned w) { return (f32x4){(float)(w & 0xffu), (float)((w >> 8) & 0xffu), (float)((w >> 16) & 0xffu), (float)(w >> 24)}; }
__device__ __forceinline__ f32x4 rcp4(f32x4 d) { return (f32x4){__builtin_amdgcn_rcpf(d[0]), __builtin_amdgcn_rcpf(d[1]), __builtin_amdgcn_rcpf(d[2]), __builtin_amdgcn_rcpf(d[3])}; }
struct EpiGateF { static constexpr bool PERM = true, AFTER_DRAIN = false, ROWMAP = false, TWOSEG = true;
    bf16_t* O; int ldo; const unsigned char* GT; int ldgB;
    __device__ __forceinline__ void mid(f32x4 (&acc)[2][2][4][2], const Unit& u, int wr, int wc, int fr, int fq) const {
        const int row0 = u.pm * BM + wr * 64 + fr, col0 = u.pn * BM + wc * 32 + 8 * fq;
#pragma unroll
        for (int ai = 0; ai < 2; ++ai) {
            u32x4 gv[4][2];
#pragma unroll
            for (int m = 0; m < 4; ++m)
#pragma unroll
                for (int bj = 0; bj < 2; ++bj) gv[m][bj] = *(const u32x4*)(GT + (size_t)(row0 + ai * HALF + m * 16) * ldgB + (size_t)((col0 + bj * HALF) >> 3) * 16);
#pragma unroll
            for (int m = 0; m < 4; ++m)
#pragma unroll
                for (int bj = 0; bj < 2; ++bj) { const u32x4 g = gv[m][bj];
                    acc[ai][bj][m][0] = acc[ai][bj][m][0] * (ub4(g.x) * rcp4(ub4(g.z)));
                    acc[ai][bj][m][1] = acc[ai][bj][m][1] * (ub4(g.y) * rcp4(ub4(g.w))); }
        }
    }
    __device__ __forceinline__ void operator()(const f32x4 (&acc)[2][2][4][2], const Unit& u, int wr, int wc, int fr, int fq) const {
        typedef unsigned u32x2l __attribute__((ext_vector_type(2)));
        const int row0 = u.pm * BM + wr * 64 + fr, col0 = u.pn * BM + wc * 32 + 8 * fq;
#pragma unroll
        for (int ai = 0; ai < 2; ++ai) {
            u32x2l gv[4][2];
#pragma unroll
            for (int m = 0; m < 4; ++m)
#pragma unroll
                for (int bj = 0; bj < 2; ++bj) gv[m][bj] = *(const u32x2l*)(GT + (size_t)(row0 + ai * HALF + m * 16) * ldgB + (size_t)((col0 + bj * HALF) >> 3) * 16 + 8);
            asm volatile("" ::: "memory");
#pragma unroll
            for (int m = 0; m < 4; ++m)
#pragma unroll
                for (int bj = 0; bj < 2; ++bj) { const u32x2l g = gv[m][bj]; const f32x4 a0 = acc[ai][bj][m][0] * (ub4(g.x) * (1.0f / 255.0f)), a1 = acc[ai][bj][m][1] * (ub4(g.y) * (1.0f / 255.0f));
                    u32x4 w; w.x = cvt_pk_bf16(a0[0], a0[1]); w.y = cvt_pk_bf16(a0[2], a0[3]); w.z = cvt_pk_bf16(a1[0], a1[1]); w.w = cvt_pk_bf16(a1[2], a1[3]);
                    *(u32x4*)(O + (size_t)(row0 + ai * HALF + m * 16) * ldo + col0 + bj * HALF) = w; }
            asm volatile("" ::: "memory");
        }
    }
};

template <class Epi, class Sched, bool ALIGN_EPI = false, bool SP2 = false>
__device__ __forceinline__ void gemm_phase(PG8_LAS unsigned char* lds, const Gemm g, const Sched& S, const Epi& E) {
    int tid_ = threadIdx.x; asm volatile("" : "+v"(tid_));
    const int tid = tid_, wid = __builtin_amdgcn_readfirstlane(tid >> 6), lane = tid & 63, wr = wid >> 2, wc = wid & 3, fr = lane & 15, fq = lane >> 4;
    const int K = g.K, nt = K / BK;
    unsigned voffA[2], voffB[2];
#pragma unroll
    for (int i = 0; i < 2; ++i) { int R, C; stage_rc(tid * 16 + i * 8192, R, C); const int Rb = Epi::PERM ? ((R & ~31) + perm32(R & 31)) : R;
        const int Ra = Epi::ROWMAP ? (128 * (R >> 6) + 4 * (R & 15) + ((R >> 4) & 3)) : R;
        voffA[i] = (unsigned)(Ra * g.lda + C) * 2u; voffB[i] = (unsigned)(Rb * g.ldb + C) * 2u; }
    const size_t kstep = (size_t)(BK * 2);
    const size_t hstepA = (size_t)(Epi::ROWMAP ? 64 : HALF) * g.lda * 2, hstepB = (size_t)HALF * g.ldb * 2;
    const size_t tstepA = (size_t)BM * g.lda * 2, tstepB = 2 * hstepB;
    const unsigned ldsw = (unsigned)wid * 1024u;
    const int aoff = lds_byte(wr * 64 + fr, fq * 8), boff = lds_byte(wc * 32 + fr, fq * 8);
#define PG8_SA(b, h) (((b) * 2 + (h)) * HTB)
#define PG8_SB(b, h) ((4 + (b) * 2 + (h)) * HTB)
#define PG8_STAGE(bufoff, gbase, voff) do { _Pragma("unroll") for (int _i = 0; _i < 2; ++_i) \
        __builtin_amdgcn_global_load_lds((const unsigned*)((const char*)(gbase) + (voff)[_i]), (PG8_LAS unsigned*)(lds + (bufoff) + ldsw + _i * 8192), 16, 0, 0); } while (0)
#define PG8_LDA(dst, b, h) do { _Pragma("unroll") for (int m = 0; m < 4; ++m) _Pragma("unroll") for (int k = 0; k < 2; ++k) dst[m][k] = *(const PG8_LAS bf16x8*)(lds + PG8_SA(b, h) + aoff + m * 2048 + k * 1024); } while (0)
#define PG8_LDB(dst, b, h) do { _Pragma("unroll") for (int n = 0; n < 2; ++n) _Pragma("unroll") for (int k = 0; k < 2; ++k) dst[n][k] = *(const PG8_LAS bf16x8*)(lds + PG8_SB(b, h) + boff + n * 2048 + k * 1024); } while (0)
#define PG8_MMA(ai, bj, At, Bt) do { __builtin_amdgcn_s_setprio(1); _Pragma("unroll") for (int m = 0; m < 4; ++m) _Pragma("unroll") for (int n = 0; n < 2; ++n) _Pragma("unroll") for (int k = 0; k < 2; ++k) \
        acc[ai][bj][m][n] = __builtin_amdgcn_mfma_f32_16x16x32_bf16(Bt[n][k], At[m][k], acc[ai][bj][m][n], 0, 0, 0); __builtin_amdgcn_s_setprio(0); } while (0)
#define PG8_WAIT_V(n) asm volatile("s_waitcnt vmcnt(" #n ")" ::: "memory")
#define PG8_WAIT_L(n) asm volatile("s_waitcnt lgkmcnt(" #n ")" ::: "memory")
#define PG8_BAR __builtin_amdgcn_s_barrier()
#define PG8_SCHED __builtin_amdgcn_sched_barrier(0)
    Unit cur, nxt; int ui = 0;
    if (!S.next(0, cur)) return;
    f32x4 acc[2][2][4][2];
#pragma unroll
    for (int a = 0; a < 2; ++a)
#pragma unroll
        for (int b = 0; b < 2; ++b)
#pragma unroll
            for (int m = 0; m < 4; ++m)
#pragma unroll
                for (int n = 0; n < 2; ++n) acc[a][b][m][n] = (f32x4){0.f, 0.f, 0.f, 0.f};
    bf16x8 At[4][2], B0[2][2], B1[2][2];
    const char* cA = (const char*)((Epi::TWOSEG && cur.seg) ? g.A2 : g.A) + (size_t)cur.pm * tstepA; const char* cB = (const char*)((Epi::TWOSEG && cur.seg) ? g.Bt2 : g.Bt) + (size_t)cur.pn * tstepB;
    S.a_ready(cur);
    if constexpr (SP2) {
        PG8_STAGE(PG8_SB(0, 0), cB, voffB); PG8_STAGE(PG8_SB(0, 1), cB + hstepB, voffB); PG8_STAGE(PG8_SA(0, 0), cA, voffA); PG8_STAGE(PG8_SA(0, 1), cA + hstepA, voffA);
        if (wr == 1) PG8_BAR;
        PG8_WAIT_V(2); PG8_BAR;
        PG8_STAGE(PG8_SB(1, 0), cB + kstep, voffB); PG8_STAGE(PG8_SA(1, 0), cA + kstep, voffA); PG8_STAGE(PG8_SB(1, 1), cB + hstepB + kstep, voffB);
        PG8_WAIT_V(6); PG8_BAR;
    } else {
        PG8_STAGE(PG8_SB(0, 0), cB, voffB); PG8_STAGE(PG8_SA(0, 0), cA, voffA); PG8_STAGE(PG8_SB(0, 1), cB + hstepB, voffB); PG8_STAGE(PG8_SA(0, 1), cA + hstepA, voffA);
        if (wr == 1) PG8_BAR;
        PG8_WAIT_V(4); PG8_BAR;
        PG8_STAGE(PG8_SB(1, 0), cB + kstep, voffB); PG8_STAGE(PG8_SA(1, 0), cA + kstep, voffA); PG8_STAGE(PG8_SB(1, 1), cB + hstepB + kstep, voffB);
        PG8_WAIT_V(6); PG8_BAR;
    }
    for (;;) {
        const bool has_next = S.next(ui + 1, nxt);
        const char* nA = has_next ? (const char*)((Epi::TWOSEG && nxt.seg) ? g.A2 : g.A) + (size_t)nxt.pm * tstepA : cA; const char* nB = has_next ? (const char*)((Epi::TWOSEG && nxt.seg) ? g.Bt2 : g.Bt) + (size_t)nxt.pn * tstepB : cB;
        for (int t = 0; t < nt; t += 2) {
            const bool last = (t == nt - 2);
            const char* a1 = cA + (size_t)(t + 1) * kstep;
            const char* a2 = last ? nA : cA + (size_t)(t + 2) * kstep; const char* b2 = last ? nB : cB + (size_t)(t + 2) * kstep;
            const char* a3 = a2 + kstep; const char* b3 = b2 + kstep;
            if (last && has_next) S.a_ready(nxt);
            if constexpr (SP2) {
            PG8_LDB(B0, 0, 0); PG8_LDB(B1, 0, 1); PG8_SCHED; PG8_LDA(At, 0, 0); PG8_STAGE(PG8_SA(1, 1), a1 + hstepA, voffA);
            PG8_WAIT_V(8); PG8_WAIT_L(0); PG8_BAR; PG8_MMA(0, 0, At, B0); PG8_MMA(0, 1, At, B1); PG8_BAR; PG8_SCHED;
            PG8_LDA(At, 0, 1); PG8_STAGE(PG8_SB(0, 0), b2, voffB); PG8_STAGE(PG8_SB(0, 1), b2 + hstepB, voffB); PG8_STAGE(PG8_SA(0, 0), a2, voffA);
            PG8_WAIT_V(8); PG8_WAIT_L(0); PG8_BAR; PG8_MMA(1, 0, At, B0); PG8_MMA(1, 1, At, B1); PG8_BAR; PG8_SCHED;
            PG8_LDB(B0, 1, 0); PG8_LDB(B1, 1, 1); PG8_SCHED; PG8_LDA(At, 1, 0); PG8_STAGE(PG8_SA(0, 1), a2 + hstepA, voffA);
            PG8_WAIT_V(8); PG8_WAIT_L(0); PG8_BAR; PG8_MMA(0, 0, At, B0); PG8_MMA(0, 1, At, B1); PG8_BAR; PG8_SCHED;
            PG8_LDA(At, 1, 1); PG8_STAGE(PG8_SB(1, 0), b3, voffB); PG8_STAGE(PG8_SB(1, 1), b3 + hstepB, voffB); PG8_STAGE(PG8_SA(1, 0), a3, voffA);
            PG8_WAIT_V(8); PG8_WAIT_L(0); PG8_BAR; PG8_MMA(1, 0, At, B0); PG8_MMA(1, 1, At, B1); PG8_BAR; PG8_SCHED;
            } else {
            PG8_LDB(B0, 0, 0); PG8_SCHED; PG8_LDA(At, 0, 0); PG8_STAGE(PG8_SA(1, 1), a1 + hstepA, voffA);
            PG8_WAIT_L(8); PG8_BAR; PG8_WAIT_L(0); PG8_MMA(0, 0, At, B0); PG8_BAR; PG8_SCHED;
            PG8_LDB(B1, 0, 1); PG8_STAGE(PG8_SB(0, 0), b2, voffB);
            PG8_BAR; PG8_WAIT_L(0); PG8_MMA(0, 1, At, B1); PG8_BAR;
            PG8_LDA(At, 0, 1); PG8_STAGE(PG8_SA(0, 0), a2, voffA);
            PG8_BAR; PG8_WAIT_L(0); PG8_MMA(1, 0, At, B0); PG8_BAR; PG8_SCHED;
            PG8_STAGE(PG8_SB(0, 1), b2 + hstepB, voffB);
            PG8_WAIT_V(6); PG8_BAR; PG8_MMA(1, 1, At, B1); PG8_BAR;
            PG8_LDB(B0, 1, 0); PG8_SCHED; PG8_LDA(At, 1, 0); PG8_STAGE(PG8_SA(0, 1), a2 + hstepA, voffA);
            PG8_WAIT_L(8); PG8_BAR; PG8_WAIT_L(0); PG8_MMA(0, 0, At, B0); PG8_BAR; PG8_SCHED;
            PG8_LDB(B1, 1, 1); PG8_STAGE(PG8_SB(1, 0), b3, voffB);
            PG8_BAR; PG8_WAIT_L(0); PG8_MMA(0, 1, At, B1); PG8_BAR;
            PG8_LDA(At, 1, 1); PG8_STAGE(PG8_SA(1, 0), a3, voffA);
            PG8_BAR; PG8_WAIT_L(0); PG8_MMA(1, 0, At, B0); PG8_BAR; PG8_SCHED;
            PG8_STAGE(PG8_SB(1, 1), b3 + hstepB, voffB);
            PG8_WAIT_V(6); PG8_BAR; PG8_MMA(1, 1, At, B1); PG8_BAR;
            }
        }
        if constexpr (ALIGN_EPI) { if (wr == 0) PG8_BAR; }
        const bool midseg = Epi::TWOSEG && cur.seg == 0;
        if constexpr (!Epi::AFTER_DRAIN) { if constexpr (Epi::TWOSEG) { if (midseg) E.mid(acc, cur, wr, wc, fr, fq); else { E(acc, cur, wr, wc, fr, fq); S.done(cur); } } else { E(acc, cur, wr, wc, fr, fq); S.done(cur); } }
        if (!has_next) break;
        if (!midseg)
#pragma unroll
        for (int a = 0; a < 2; ++a)
#pragma unroll
            for (int b = 0; b < 2; ++b)
#pragma unroll
                for (int m = 0; m < 4; ++m)
#pragma unroll
                    for (int n = 0; n < 2; ++n) acc[a][b][m][n] = (f32x4){0.f, 0.f, 0.f, 0.f};
        cur = nxt; cA = nA; cB = nB; ++ui;
        if constexpr (ALIGN_EPI) { if (wr == 1) PG8_BAR; }
    }
    PG8_WAIT_V(0);
    if constexpr (!ALIGN_EPI) { if (wr == 0) PG8_BAR; }
    PG8_BAR;
    if constexpr (Epi::AFTER_DRAIN) { E.fused(acc, cur, wr, wc, fr, fq, lds, wid, lane); S.done(cur); }
#undef PG8_SA
#undef PG8_SB
#undef PG8_STAGE
#undef PG8_LDA
#undef PG8_LDB
#undef PG8_MMA
#undef PG8_WAIT_V
#undef PG8_WAIT_L
#undef PG8_BAR
#undef PG8_SCHED
}
}
constexpr int NWAVES = 8, NTHR = NWAVES * 64;
constexpr int NL = 4, NB = 16, SEQ = 2048, DM = 2048, MR = NB * SEQ;
constexpr int NIN = 8192, DFF = 5504, NUP = 2 * DFF, DS = 1024, NG = 64, NPS = 64, NIS = 16, NH = 8;
constexpr int OFF_K = 1024, OFF_V = 2048, OFF_U = 3072, OFF_GA = 4096, OFF_GS = 6144;
constexpr float EPS = 1e-6f, LOG2E = 1.4426950408889634f, QSCALE = 0.125f * LOG2E;
constexpr int PH_PER_LAYER = 9, N_PHASES = 1 + NL * PH_PER_LAYER;

constexpr size_t MiB = 1u << 20;
constexpr size_t WS_CTL = 0, CTL_ZERO_BYTES = 1 * MiB;
constexpr size_t WS_WIN = 2 * MiB, WS_WGLU = 34 * MiB, WS_WBA = 36 * MiB, WS_WBS = 40 * MiB, WS_WOUT = 44 * MiB, WS_WUP = 52 * MiB, WS_WDN = 95 * MiB;
constexpr size_t WS_RSTD = 1280 * MiB;
constexpr size_t WS_XB = 120 * MiB;
constexpr size_t WS_PROJ = 248 * MiB;
constexpr size_t WS_YG = 1104 * MiB, WS_Y2 = 1284 * MiB, WS_ON = 888 * MiB;
constexpr size_t WS_MIX = 952 * MiB;
constexpr size_t WS_RAW = 248 * MiB;
constexpr size_t WS_G = 936 * MiB;
constexpr size_t WS_BTY = 1080 * MiB, WS_BTS = 1092 * MiB, WS_KTAB = 1100 * MiB;
constexpr size_t WS_S = 824 * MiB;
constexpr size_t WS_UCAT = 1168 * MiB;
constexpr size_t WS_END = 1348 * MiB;
constexpr int CW_BAR = 4096;

constexpr int RING_BYTES = 131072, LDSCTL_OFF = RING_BYTES, MISC_OFF = LDSCTL_OFF + 320, LDS_BYTES = 147456;

#define GAS __attribute__((address_space(1)))
#define LAS __attribute__((address_space(3)))
typedef unsigned short bf16;
typedef unsigned v4u __attribute__((ext_vector_type(4)));
typedef float f32x4 __attribute__((ext_vector_type(4)));
typedef short bf16x8 __attribute__((ext_vector_type(8)));
typedef GAS unsigned gu32;
typedef GAS unsigned long long gu64;
#define RLX_AGENT __ATOMIC_RELAXED, __HIP_MEMORY_SCOPE_AGENT
#define LDS_WAIT() asm volatile("s_waitcnt lgkmcnt(0)" ::: "memory")
#define VM_WAIT() asm volatile("s_waitcnt vmcnt(0)" ::: "memory")
__device__ __forceinline__ unsigned long long rt() { return __builtin_amdgcn_s_memrealtime(); }
__device__ __forceinline__ unsigned f2bf(float f) { unsigned u = __builtin_bit_cast(unsigned, f); return (u + 0x7fffu + ((u >> 16) & 1u)) >> 16; }
__device__ __forceinline__ unsigned pk2(float lo, float hi) { return f2bf(lo) | (f2bf(hi) << 16); }

#define XB_TMO      128
#define XB_XCNT(j)  (256  + 64 * (j))
#define XB_XSUB(j)  (1280 + 64 * (j))
#define XB_XGEN(j)  (2304 + 64 * (j))
#define XB_TOP      3328
#define XB_TOPGEN   3392
#define XCD_BAR_WORDS 3456
#define XB_SPIN_CAP (1u << 18)

__device__ __forceinline__ unsigned xb_ld(unsigned* p)              { return __hip_atomic_load(p, __ATOMIC_RELAXED, __HIP_MEMORY_SCOPE_AGENT); }
__device__ __forceinline__ unsigned xb_add(unsigned* p, unsigned v) { return __hip_atomic_fetch_add(p, v, __ATOMIC_RELAXED, __HIP_MEMORY_SCOPE_AGENT); }
__device__ __forceinline__ unsigned xb_xcc_id() { return (unsigned)__builtin_amdgcn_s_getreg((3 << 11) | 20) & 0xFu; }
#define XB_SPIN(cond, bar) do { unsigned _sp = 0; while (cond) { __builtin_amdgcn_s_sleep(1); \
    if ((++_sp & 255u) == 0u) { if (xb_ld(&(bar)[XB_TMO])) break; if (_sp > XB_SPIN_CAP) { atomicAdd(&(bar)[XB_TMO], 1u); break; } } } } while (0)

struct XcdBarrier {
    unsigned* bar; unsigned x;
    volatile LAS unsigned* st;
};

__device__ __forceinline__ XcdBarrier xcd_barrier_post(unsigned* bar, volatile LAS unsigned* st) {
    XcdBarrier b; b.bar = bar; b.x = xb_xcc_id(); b.st = st;
    if (threadIdx.x == 0) st[3] = xb_add(&bar[XB_XCNT(b.x)], 1u);
    return b;
}
__device__ __forceinline__ void xcd_barrier_complete(unsigned* bar, unsigned x, unsigned& nloc, unsigned& nx, unsigned& even) {
    const unsigned G = gridDim.x * gridDim.y * gridDim.z;
    unsigned sum, cnt, mine, ev, sp = 0u;
    for (;;) {
        sum = 0u; cnt = 0u; mine = 0u; ev = (G % 8u == 0u) ? 1u : 0u;
#pragma unroll
        for (unsigned j = 0; j < 16; ++j) { const unsigned c = xb_ld(&bar[XB_XCNT(j)]); sum += c; cnt += (c > 0u) ? 1u : 0u; mine = (j == x) ? c : mine; if (j < 8u && c * 8u != G) ev = 0u; }
        if (sum == G) break;
        __builtin_amdgcn_s_sleep(1);
        if ((++sp & 255u) == 0u) { if (xb_ld(&bar[XB_TMO])) break; if (sp > XB_SPIN_CAP) { atomicAdd(&bar[XB_TMO], 1u); break; } }
    }
    nloc = mine > 0u ? mine : 1u; nx = cnt > 0u ? cnt : 1u; even = (sum == G) ? ev : 0u;
}

__device__ __forceinline__ void xcd_barrier(const XcdBarrier& b) {
    asm volatile("s_waitcnt vmcnt(0)" ::: "memory");
    __syncthreads();
    if (threadIdx.x == 0) {
        unsigned* bar = b.bar;
        __builtin_amdgcn_s_waitcnt(0);
        unsigned nloc = b.st[0], nx = b.st[1];
        if (nloc == 0u) { unsigned even; xcd_barrier_complete(bar, b.x, nloc, nx, even); b.st[0] = nloc; b.st[1] = nx; b.st[2] = even; }
        const unsigned old = xb_add(&bar[XB_XSUB(b.x)], 1u);
        const unsigned gen = old / nloc;
        if (old + 1u == (gen + 1u) * nloc) {
            __builtin_amdgcn_fence(__ATOMIC_RELEASE, "agent");
            asm volatile("s_waitcnt vmcnt(0)" ::: "memory");
            const unsigned og = xb_add(&bar[XB_TOP], 1u);
            const unsigned tg = og / nx;
            if (og + 1u == (tg + 1u) * nx) xb_add(&bar[XB_TOPGEN], 1u);
            else XB_SPIN(xb_ld(&bar[XB_TOPGEN]) == tg, bar);
            __builtin_amdgcn_fence(__ATOMIC_ACQUIRE, "agent");
            xb_add(&bar[XB_XGEN(b.x)], 1u);
            asm volatile("s_waitcnt vmcnt(0)" ::: "memory");
        } else {
            XB_SPIN(xb_ld(&bar[XB_XGEN(b.x)]) == gen, bar);
            __builtin_amdgcn_fence(__ATOMIC_ACQUIRE, "agent");
            asm volatile("s_waitcnt vmcnt(0)" ::: "memory");
        }
    }
    __syncthreads();
}
__device__ __forceinline__ void xcd_barrier_local(const XcdBarrier& b) {
    asm volatile("s_waitcnt vmcnt(0)" ::: "memory");
    __syncthreads();
    if (threadIdx.x == 0) {
        unsigned* bar = b.bar;
        __builtin_amdgcn_s_waitcnt(0);
        const unsigned nloc = b.st[0];
        const unsigned old = xb_add(&bar[XB_XSUB(b.x)], 1u);
        const unsigned gen = old / nloc;
        if (old + 1u == (gen + 1u) * nloc) xb_add(&bar[XB_XGEN(b.x)], 1u);
        else XB_SPIN(xb_ld(&bar[XB_XGEN(b.x)]) == gen, bar);
        __builtin_amdgcn_fence(__ATOMIC_ACQUIRE, "agent");
        asm volatile("s_waitcnt vmcnt(0)" ::: "memory");
    }
    __syncthreads();
}
using pg8::bf_lo; using pg8::bf_hi; using pg8::sigm; using pg8::gelu_t;
struct Args { const float* in[28]; float* out; unsigned char* ws; int ph_lo, ph_hi; };
typedef const __attribute__((address_space(4))) Args* KArgsP;
__device__ __forceinline__ KArgsP fresh_args() { KArgsP p = (KArgsP)__builtin_amdgcn_kernarg_segment_ptr(); asm volatile("" : "+s"(p)); return p; }

__device__ __forceinline__ float wave_sum(float v) {
#pragma unroll
    for (int o = 1; o < 64; o <<= 1) v += __shfl_xor(v, o);
    return v;
}
__device__ __forceinline__ void transpose_item(const float* W, int K, int N, const float* gk, bf16* WT, LAS float* scr, int item, int lane, int rmap = 0) {
    const int nblk = N / 32, kb = item / nblk, nb = item % nblk, k0 = 64 * kb, n0 = 32 * nb;
    { const int kr = lane >> 3, nq = lane & 7; f32x4 v[8];
#pragma unroll
      for (int i = 0; i < 8; ++i) v[i] = *(const GAS f32x4*)(W + (size_t)(k0 + kr + 8 * i) * N + n0 + 4 * nq);
#pragma unroll
      for (int i = 0; i < 8; ++i) { const int kk = kr + 8 * i; const float gs = gk ? gk[k0 + kk] : 1.0f; LAS float* d = scr + kk * 33 + 4 * nq; d[0] = v[i].x * gs; d[1] = v[i].y * gs; d[2] = v[i].z * gs; d[3] = v[i].w * gs; } }
    LDS_WAIT(); asm volatile("" ::: "memory");
    const int c = lane & 7;
#pragma unroll
    for (int j = 0; j < 4; ++j) { const int n = (lane >> 3) + 8 * j; const LAS float* s = scr + (8 * c) * 33 + n;
        v4u o; o.x = pk2(s[0 * 33], s[1 * 33]); o.y = pk2(s[2 * 33], s[3 * 33]); o.z = pk2(s[4 * 33], s[5 * 33]); o.w = pk2(s[6 * 33], s[7 * 33]);
        int nd = n0;
        if (rmap == 1) nd = (n0 < DFF) ? 256 * (n0 / 128) + (n0 % 128) : 256 * ((n0 - DFF) / 128) + 128 + ((n0 - DFF) % 128);
        if (rmap == 2 && n0 < 2048) nd = 256 * (n0 / 256) + 128 * ((n0 % 64) / 32) + 32 * ((n0 % 256) / 64);
        if (rmap == 2 && n0 >= 4096) { const int c = (n0 - 4096) % 2048; nd = 4096 + 256 * (c / 128) + (c % 128) + (n0 >= 6144 ? 128 : 0); }
        *(GAS v4u*)(WT + (size_t)(nd + n) * K + k0 + 8 * c) = o; }
    LDS_WAIT(); asm volatile("" ::: "memory");
}
constexpr int CONV_I_IN = (DM / 64) * (NIN / 32);
__device__ __forceinline__ void ph_convert(KArgsP ap, LAS unsigned char* lds, int l, int gw, int NGW, int wave, int lane, int it_lo = 0, int it_hi = 1 << 30) {
    LAS float* scr = (LAS float*)(lds + wave * 16384);
    unsigned char* ws = ap->ws;
    constexpr int I_IN = (DM / 64) * (NIN / 32), I_GLU = (DS / 64) * (DS / 32), I_BA = (DS / 64) * (DM / 32), I_OUT = (DM / 64) * (DM / 32), I_UP = (DM / 64) * (NUP / 32), I_DN = (DFF / 64) * (DM / 32);
    constexpr int NITEMS = I_IN + I_GLU + 2 * I_BA + I_OUT + I_UP + I_DN;
    static_assert(I_IN == CONV_I_IN, "");
    if (it_hi > NITEMS) it_hi = NITEMS;
    for (int it = it_lo + gw; it < it_hi; it += NGW) {
        int r = it;
        if (r < I_IN)  { transpose_item(ap->in[2] + (size_t)l * DM * NIN, DM, NIN, ap->in[1] + (size_t)l * DM, (bf16*)(ws + WS_WIN), scr, r, lane, 2); continue; } r -= I_IN;
        if (r < I_GLU) { transpose_item(ap->in[18] + (size_t)l * DS * DS, DS, DS, nullptr, (bf16*)(ws + WS_WGLU), scr, r, lane); continue; } r -= I_GLU;
        if (r < I_BA)  { transpose_item(ap->in[20] + (size_t)l * DS * DM, DS, DM, nullptr, (bf16*)(ws + WS_WBA), scr, r, lane); continue; } r -= I_BA;
        if (r < I_BA)  { transpose_item(ap->in[21] + (size_t)l * DS * DM, DS, DM, nullptr, (bf16*)(ws + WS_WBS), scr, r, lane); continue; } r -= I_BA;
        if (r < I_OUT) { transpose_item(ap->in[22] + (size_t)l * DM * DM, DM, DM, nullptr, (bf16*)(ws + WS_WOUT), scr, r, lane); continue; } r -= I_OUT;
        if (r < I_UP)  { transpose_item(ap->in[24] + (size_t)l * DM * NUP, DM, NUP, ap->in[23] + (size_t)l * DM, (bf16*)(ws + WS_WUP), scr, r, lane, 1); continue; } r -= I_UP;
        transpose_item(ap->in[27] + (size_t)l * DFF * DM, DFF, DM, nullptr, (bf16*)(ws + WS_WDN), scr, r, lane);
    }
}
__device__ __forceinline__ void ph_xprep(const float* src, bf16* xb, float* ssq, int gw, int NGW, int lane) {
    for (int m = gw; m < MR; m += NGW) {
        const GAS f32x4* xr = (const GAS f32x4*)(src + (size_t)m * DM) + lane;
        f32x4 v[8]; float s = 0.f;
#pragma unroll
        for (int j = 0; j < 8; ++j) { v[j] = xr[64 * j]; s += (v[j].x * v[j].x + v[j].y * v[j].y) + (v[j].z * v[j].z + v[j].w * v[j].w); }
        s = wave_sum(s);
        if (lane < 32) ssq[(size_t)m * 32 + lane] = (lane == 0) ? s : 0.f;
        GAS unsigned long long* o8 = (GAS unsigned long long*)(xb + (size_t)m * DM) + lane;
#pragma unroll
        for (int j = 0; j < 8; ++j) { const unsigned h0 = pk2(v[j].x, v[j].y), h1 = pk2(v[j].z, v[j].w); o8[64 * j] = (unsigned long long)h0 | ((unsigned long long)h1 << 32); }
    }
}
__device__ __forceinline__ void ph_conv_fix(KArgsP ap, int l, int vcu, int G, int tid) {
    const bf16* RAW = (const bf16*)(ap->ws + WS_RAW); bf16* Gb = (bf16*)(ap->ws + WS_G);
    const float* cw = ap->in[25] + (size_t)l * 3 * NUP; const float* cb = ap->in[26] + (size_t)l * NUP;
    constexpr int NF8 = DFF / 8; constexpr long total = (long)(MR / 256) * 4 * NF8;
    const bool grp = (G % 8 == 0); const int per = grp ? G / 8 : G; const long it0 = grp ? (long)(vcu / per) * (total / 8) : 0, it1 = grp ? it0 + total / 8 : total, NT = (long)per * NTHR;
    for (long it = it0 + (long)(grp ? vcu % per : vcu) * NTHR + tid; it < it1; it += NT) {
        const int f = (int)(it % NF8) * 8, q = (int)(it / NF8), r = q & 1, which = (q >> 1) & 1, pm = q >> 2;
        float av[8], vv[8];
        { const f32x4 b0 = *(const f32x4*)(cb + f), b1 = *(const f32x4*)(cb + f + 4), b2 = *(const f32x4*)(cb + DFF + f), b3 = *(const f32x4*)(cb + DFF + f + 4);
          av[0] = b0.x; av[1] = b0.y; av[2] = b0.z; av[3] = b0.w; av[4] = b1.x; av[5] = b1.y; av[6] = b1.z; av[7] = b1.w;
          vv[0] = b2.x; vv[1] = b2.y; vv[2] = b2.z; vv[3] = b2.w; vv[4] = b3.x; vv[5] = b3.y; vv[6] = b3.z; vv[7] = b3.w; }
#pragma unroll
        for (int jj = 0; jj < 3; ++jj) {
            const int sq = r + jj;
            const bf16* src;
            if (which == 1) src = RAW + ((size_t)pm * 8 + 2 + sq) * NUP;
            else if (sq >= 2) src = RAW + ((size_t)pm * 8 + (sq - 2)) * NUP;
            else { if ((pm & 7) == 0) continue; src = RAW + ((size_t)(pm - 1) * 8 + 6 + sq) * NUP; }
            const v4u wa = *(const GAS v4u*)(src + f), wv = *(const GAS v4u*)(src + DFF + f);
            const float* c0 = cw + (size_t)jj * NUP + f;
            const f32x4 ca0 = *(const f32x4*)c0, ca1 = *(const f32x4*)(c0 + 4), cv0 = *(const f32x4*)(c0 + DFF), cv1 = *(const f32x4*)(c0 + DFF + 4);
            av[0] += ca0.x * bf_lo(wa.x); av[1] += ca0.y * bf_hi(wa.x); av[2] += ca0.z * bf_lo(wa.y); av[3] += ca0.w * bf_hi(wa.y);
            av[4] += ca1.x * bf_lo(wa.z); av[5] += ca1.y * bf_hi(wa.z); av[6] += ca1.z * bf_lo(wa.w); av[7] += ca1.w * bf_hi(wa.w);
            vv[0] += cv0.x * bf_lo(wv.x); vv[1] += cv0.y * bf_hi(wv.x); vv[2] += cv0.z * bf_lo(wv.y); vv[3] += cv0.w * bf_hi(wv.y);
            vv[4] += cv1.x * bf_lo(wv.z); vv[5] += cv1.y * bf_hi(wv.z); vv[6] += cv1.z * bf_lo(wv.w); vv[7] += cv1.w * bf_hi(wv.w); }
        v4u o; o.x = pk2(gelu_t(av[0]) * vv[0], gelu_t(av[1]) * vv[1]); o.y = pk2(gelu_t(av[2]) * vv[2], gelu_t(av[3]) * vv[3]);
        o.z = pk2(gelu_t(av[4]) * vv[4], gelu_t(av[5]) * vv[5]); o.w = pk2(gelu_t(av[6]) * vv[6], gelu_t(av[7]) * vv[7]);
        *(GAS v4u*)(Gb + (size_t)(256 * pm + 128 * which + r) * DFF + f) = o;
    }
}
namespace att {
typedef short bf16x8 __attribute__((ext_vector_type(8)));
typedef short s16x4 __attribute__((ext_vector_type(4)));
typedef float f32x16 __attribute__((ext_vector_type(16)));
typedef unsigned u32x4 __attribute__((ext_vector_type(4)));
__device__ __forceinline__ int crow(int r, int hi) { return (r & 3) + 8 * (r >> 2) + 4 * hi; }
__device__ __forceinline__ s16x4 vtr(const LAS unsigned char* p) { return __builtin_bit_cast(s16x4, __builtin_amdgcn_ds_read_tr16_b64_v4i16((LAS s16x4*)p)); }
__device__ __forceinline__ void glds16(const void* gsrc, unsigned lds_dst) { unsigned keep;
    asm volatile("s_mov_b32 %0, m0\n\ts_mov_b32 m0, %2\n\ts_nop 0\n\tglobal_load_lds_dwordx4 %1, off\n\ts_mov_b32 m0, %0" : "=&s"(keep) : "v"(gsrc), "s"(lds_dst) : "memory"); }
__device__ __forceinline__ void glds16s(const void* base, unsigned voff, unsigned lds_dst) { unsigned keep;
    asm volatile("s_mov_b32 %0, m0\n\ts_mov_b32 m0, %3\n\ts_nop 0\n\tglobal_load_lds_dwordx4 %1, %2\n\ts_mov_b32 m0, %0" : "=&s"(keep) : "v"(voff), "s"(base), "s"(lds_dst) : "memory"); }
constexpr int WSF_OFF = LDSCTL_OFF + 1024;
}
__device__ __forceinline__ void ph_attn_mfma(KArgsP ap, LAS unsigned char* lds, int l, int vcu, int G, int wave, int lane) {
    using namespace att;
    const bf16* PROJ = (const bf16*)(ap->ws + WS_PROJ); bf16* ON = (bf16*)(ap->ws + WS_ON);
    const int r32 = lane & 31, hi = lane >> 5, c = wave >> 2, wq = wave & 3;
    float s1 = 0.f, s2 = 0.f;
    for (int d = 0; d < 64; ++d) { s1 += ap->in[5][l * 64 + d] * ap->in[6][l * 64 + d]; s2 += ap->in[7][l * 64 + d] * ap->in[8][l * 64 + d]; }
    const float lam_init = 0.8f - 0.6f * __builtin_amdgcn_exp2f(-0.3f * LOG2E * (float)l), lam = __builtin_amdgcn_exp2f(s1 * LOG2E) - __builtin_amdgcn_exp2f(s2 * LOG2E) + lam_init;
    const float* sg = ap->in[9] + l * 128;
    LAS float* XCH = (LAS float*)lds;
    LAS float* wsf = (LAS float*)(lds + WSF_OFF) + wave * 64;
    const unsigned lds0 = (unsigned)(uintptr_t)lds;
    const unsigned voffK = (unsigned)((lane * NIN + 2 * wave * 8) * 2);
    const unsigned voffV0 = (unsigned)(((16 * (2 * (wave & 1)) + (lane >> 2)) * NIN + (wave >> 1) * 32 + (lane & 3) * 8) * 2), voffV1 = voffV0 + (unsigned)(16 * NIN * 2);
    const int sper = (G % 8 == 0) ? G / 8 : G, sbase = (G % 8 == 0) ? (vcu / sper) * (NB * NH) : 0, slim = (G % 8 == 0) ? NB * NH : NB * NH * 8;
    for (int sl = (G % 8 == 0) ? vcu % sper : vcu; sl < slim; sl += sper) { const int su = sbase + sl;
        const int bh = su >> 3, pi = su & 7, b = bh >> 3, h = bh & 7;
        const float sl2 = __builtin_amdgcn_exp2f(-(float)(h + 1)) * LOG2E;
        const bf16* Kg = PROJ + (size_t)b * SEQ * NIN + OFF_K + h * 128;
        const bf16* Vg = PROJ + (size_t)b * SEQ * NIN + OFF_V + h * 128;
#pragma unroll 1
        for (int half = 0; half < 2; ++half) {
            const int qb = half ? 15 - pi : pi, NT = 2 * qb + 2, myNT = (wq < 2) ? NT - 1 : NT, q0 = 128 * qb;
            const bf16* Qw = PROJ + ((size_t)b * SEQ + q0 + 32 * wq + r32) * NIN + h * 128 + c * 64;
#define ATT_STAGE_K(tt) do { const bf16* kb2_ = Kg + (size_t)(64 * (tt)) * NIN; const unsigned ld_ = (unsigned)__builtin_amdgcn_readfirstlane((int)(lds0 + ((tt) & 3) * 32768 + 2 * wave * 1024)); \
                glds16s(kb2_, voffK, ld_); glds16s(kb2_, voffK + 16u, ld_ + 1024u); } while (0)
#define ATT_STAGE_V(tt) do { const bf16* vb2_ = Vg + (size_t)(64 * (tt)) * NIN; const unsigned ld_ = (unsigned)__builtin_amdgcn_readfirstlane((int)(lds0 + ((tt) & 3) * 32768 + 16384 + 2 * wave * 1024)); \
                glds16s(vb2_, voffV0, ld_); glds16s(vb2_, voffV1, ld_ + 1024u); } while (0)
#define ATT_QK(tt, P0, P1, C0, C1) do { const LAS unsigned char* kb_ = lds + ((tt) & 3) * 32768 + (8 * c + hi) * 1024 + r32 * 16; \
                bf16x8 kf_[8]; \
                _Pragma("unroll") for (int d0 = 0; d0 < 4; ++d0) { kf_[2 * d0] = *(const LAS bf16x8*)(kb_ + d0 * 2048); kf_[2 * d0 + 1] = *(const LAS bf16x8*)(kb_ + d0 * 2048 + 512); } \
                __builtin_amdgcn_sched_barrier(0); __builtin_amdgcn_s_setprio(1); \
                P0 = __builtin_amdgcn_mfma_f32_32x32x16_bf16(kf_[0], qr[0], C0, 0, 0, 0); P1 = __builtin_amdgcn_mfma_f32_32x32x16_bf16(kf_[1], qr[0], C1, 0, 0, 0); \
                _Pragma("unroll") for (int d0 = 1; d0 < 4; ++d0) { P0 = __builtin_amdgcn_mfma_f32_32x32x16_bf16(kf_[2 * d0], qr[d0], P0, 0, 0, 0); P1 = __builtin_amdgcn_mfma_f32_32x32x16_bf16(kf_[2 * d0 + 1], qr[d0], P1, 0, 0, 0); } \
                __builtin_amdgcn_s_setprio(0); __builtin_amdgcn_sched_barrier(0); } while (0)
            bf16x8 qr[4];
#pragma unroll
            for (int d0 = 0; d0 < 4; ++d0) qr[d0] = *(const bf16x8*)(Qw + d0 * 16 + hi * 8);
            asm volatile("" : "+v"(qr[0]), "+v"(qr[1]), "+v"(qr[2]), "+v"(qr[3]) :: "memory");
            ATT_STAGE_K(0); ATT_STAGE_V(0); ATT_STAGE_K(1); ATT_STAGE_V(1);
            if (NT > 2) { ATT_STAGE_K(2); ATT_STAGE_V(2); }
            f32x16 o[4];
#pragma unroll
            for (int d0 = 0; d0 < 4; ++d0)
#pragma unroll
                for (int r = 0; r < 16; ++r) o[d0][r] = 0.f;
            float mrun = 0.f, l_reg = 0.f;
            const float qd = (float)(q0 + 32 * wq + r32 - 4 * hi);
            f32x16 B0, B1;
#pragma unroll
            for (int r = 0; r < 16; ++r) { const float kr = (float)((r & 3) + 8 * (r >> 2)); B0[r] = -sl2 * (qd - kr); B1[r] = -sl2 * (qd - 32.0f - kr); }
            const float bstep = 64.0f * sl2;
#pragma unroll 1
            for (int t = 0; t < NT; ++t) {
                if (t + 2 < NT) asm volatile("s_waitcnt vmcnt(8) lgkmcnt(0)\n\ts_barrier" ::: "memory"); else asm volatile("s_waitcnt vmcnt(0) lgkmcnt(0)\n\ts_barrier" ::: "memory");
                if (t + 3 < NT) { ATT_STAGE_K(t + 3); ATT_STAGE_V(t + 3); }
                if (t < myNT) {
                    const LAS unsigned char* Vb = lds + (t & 3) * 32768 + 16384;
                    if (t == myNT - 1) {
                        const float dq = qd - (float)(64 * t);
#pragma unroll
                        for (int r = 0; r < 16; ++r) { const float kr = (float)((r & 3) + 8 * (r >> 2)); B0[r] = -sl2 * __builtin_fabsf(dq - kr) - mrun; B1[r] = -sl2 * __builtin_fabsf(dq - 32.0f - kr) - mrun; }
                    }
                    f32x16 p0, p1;
                    ATT_QK(t, p0, p1, B0, B1);
                    float rm = fmaxf(p0[0], p1[0]);
#pragma unroll
                    for (int r = 1; r < 16; ++r) rm = fmaxf(fmaxf(rm, p0[r]), p1[r]);
                    { auto rr = __builtin_amdgcn_permlane32_swap(__float_as_uint(rm), __float_as_uint(rm), false, false); rm = fmaxf(__uint_as_float(rr[0]), __uint_as_float(rr[1])); }
                    if (__builtin_amdgcn_ballot_w64(rm > 8.0f) != 0ull) {
                        const float dl = fmaxf(rm, 0.f), f = __builtin_amdgcn_exp2f(-dl); mrun += dl; l_reg *= f;
                        p0 = p0 - dl; p1 = p1 - dl; B0 = B0 - dl; B1 = B1 - dl;
                        if (hi == 0) wsf[r32] = f;
#pragma unroll
                        for (int r = 0; r < 16; ++r) { const float fr_ = wsf[crow(r, hi)];
#pragma unroll
                            for (int d0 = 0; d0 < 4; ++d0) o[d0][r] *= fr_; }
                    }
#pragma unroll
                    for (int r = 0; r < 16; ++r) { p0[r] = __builtin_amdgcn_exp2f(p0[r]); p1[r] = __builtin_amdgcn_exp2f(p1[r]); }
                    { const f32x16 sv = p0 + p1; float sacc = ((sv[0] + sv[1]) + (sv[2] + sv[3])) + ((sv[4] + sv[5]) + (sv[6] + sv[7])) + ((sv[8] + sv[9]) + (sv[10] + sv[11])) + ((sv[12] + sv[13]) + (sv[14] + sv[15])); l_reg += sacc; }
                    u32x4 pw[4];
#pragma unroll
                    for (int j = 0; j < 4; ++j) { pw[0][j] = pg8::cvt_pk_bf16(p0[2 * j], p0[2 * j + 1]); pw[1][j] = pg8::cvt_pk_bf16(p0[8 + 2 * j], p0[8 + 2 * j + 1]);
                        pw[2][j] = pg8::cvt_pk_bf16(p1[2 * j], p1[2 * j + 1]); pw[3][j] = pg8::cvt_pk_bf16(p1[8 + 2 * j], p1[8 + 2 * j + 1]); }
                    const LAS unsigned char* vp0 = Vb + ((lane >> 4) & 1) * 32 + (lane & 3) * 8 + (4 * hi + ((lane & 15) >> 2)) * 64;
                    { s16x4 vl[2][4], vh[2][4];
#pragma unroll
                      for (int ks = 0; ks < 4; ++ks) { vl[0][ks] = vtr(vp0 + ks * 1024); vh[0][ks] = vtr(vp0 + ks * 1024 + 512); }
                      __builtin_amdgcn_sched_barrier(0);
#pragma unroll
                      for (int d0 = 0; d0 < 4; ++d0) {
                          if (d0 < 3) {
#pragma unroll
                              for (int ks = 0; ks < 4; ++ks) { vl[(d0 + 1) & 1][ks] = vtr(vp0 + (d0 + 1) * 4096 + ks * 1024); vh[(d0 + 1) & 1][ks] = vtr(vp0 + (d0 + 1) * 4096 + ks * 1024 + 512); } }
                          __builtin_amdgcn_sched_barrier(0);
#pragma unroll
                          for (int ks = 0; ks < 4; ++ks) { const s16x4 a = vl[d0 & 1][ks], bq = vh[d0 & 1][ks]; const bf16x8 vf = (bf16x8){a[0], a[1], a[2], a[3], bq[0], bq[1], bq[2], bq[3]};
                              o[d0] = __builtin_amdgcn_mfma_f32_32x32x16_bf16(__builtin_bit_cast(bf16x8, pw[ks]), vf, o[d0], 0, 0, 0); }
                          __builtin_amdgcn_sched_barrier(0);
                      } }
                    B0 = B0 + bstep; B1 = B1 + bstep;
                }
            }
#undef ATT_STAGE_K
#undef ATT_STAGE_V
#undef ATT_QK
            { auto rr = __builtin_amdgcn_permlane32_swap(__float_as_uint(l_reg), __float_as_uint(l_reg), false, false); l_reg = __uint_as_float(rr[0]) + __uint_as_float(rr[1]); }
            if (hi == 0) wsf[r32] = __builtin_amdgcn_rcpf(l_reg);
            float il[16];
#pragma unroll
            for (int r = 0; r < 16; ++r) il[r] = wsf[crow(r, hi)];
            __syncthreads();
            if (c == 1) {
#pragma unroll
                for (int d0 = 0; d0 < 4; ++d0)
#pragma unroll
                    for (int r = 0; r < 16; ++r) XCH[(32 * wq + crow(r, hi)) * 128 + 32 * d0 + r32] = o[d0][r] * il[r]; }
            __syncthreads();
            if (c == 0) {
#pragma unroll
                for (int d0 = 0; d0 < 4; ++d0)
#pragma unroll
                    for (int r = 0; r < 16; ++r) { const int ix = (32 * wq + crow(r, hi)) * 128 + 32 * d0 + r32; XCH[ix] = o[d0][r] * il[r] - lam * XCH[ix]; } }
            __syncthreads();
            { const int row = 16 * wave + (lane >> 2), qq = lane & 3;
              const LAS f32x4* xp = (const LAS f32x4*)(XCH + row * 128 + 32 * qq);
              f32x4 x[8]; float ss = 0.f;
#pragma unroll
              for (int i = 0; i < 8; ++i) { x[i] = xp[i]; ss += (x[i].x * x[i].x + x[i].y * x[i].y) + (x[i].z * x[i].z + x[i].w * x[i].w); }
              ss += __shfl_xor(ss, 1); ss += __shfl_xor(ss, 2);
              const float sc = __builtin_amdgcn_rsqf(ss * (1.0f / 128.0f) + EPS) * (1.0f - lam_init);
              GAS v4u* op = (GAS v4u*)(ON + ((size_t)b * SEQ + q0 + row) * DS + h * 128 + 32 * qq);
#pragma unroll
              for (int i = 0; i < 4; ++i) { const f32x4 g0 = *(const f32x4*)(sg + 32 * qq + 8 * i), g1 = *(const f32x4*)(sg + 32 * qq + 8 * i + 4); const f32x4 xa = x[2 * i], xb = x[2 * i + 1]; v4u w;
                  w.x = pk2(xa.x * sc * g0.x, xa.y * sc * g0.y); w.y = pk2(xa.z * sc * g0.z, xa.w * sc * g0.w); w.z = pk2(xb.x * sc * g1.x, xb.y * sc * g1.y); w.w = pk2(xb.z * sc * g1.z, xb.w * sc * g1.w); op[i] = w; } }
            __syncthreads();
        }
    }
    __syncthreads();
}
struct SsmPar { float dt, ar, ai, ph1; };
__device__ __forceinline__ SsmPar ssm_par(KArgsP ap, int l, int g, int p) {
    SsmPar q; q.dt = __builtin_amdgcn_exp2f(ap->in[12][(size_t)l * NG + g] * LOG2E); q.ar = ap->in[10][((size_t)l * NG + g) * NPS + p]; q.ai = ap->in[11][((size_t)l * NG + g) * NPS + p];
    q.ph1 = q.dt * q.ai * 0.15915494309189535f; return q;
}
__device__ __forceinline__ void ssm_apow(const SsmPar& q, float n, float& re, float& im) {
    const float mag = __builtin_amdgcn_exp2f(n * q.dt * q.ar * LOG2E), ph = __builtin_amdgcn_fractf(n * q.ph1);
    re = mag * __builtin_amdgcn_cosf(ph); im = mag * __builtin_amdgcn_sinf(ph);
}
__device__ __forceinline__ void ssm_f(const SsmPar& q, float& fre, float& fim) {
    float a1r, a1i; ssm_apow(q, 1.0f, a1r, a1i);
    const float iden = __builtin_amdgcn_rcpf(q.ar * q.ar + q.ai * q.ai), zr = a1r - 1.0f, zi = a1i; fre = (zr * q.ar + zi * q.ai) * iden; fim = (zi * q.ar - zr * q.ai) * iden;
}
__device__ __forceinline__ void ph_ssm_prep1(KArgsP ap, int l, int gw, int NGW, int lane) {
    float* Ktab = (float*)(ap->ws + WS_KTAB);
    const float* bre = ap->in[13] + (size_t)l * NG * NPS * NIS; const float* bim = ap->in[14] + (size_t)l * NG * NPS * NIS;
    const float* cre = ap->in[15] + (size_t)l * NG * NIS * NPS; const float* cim = ap->in[16] + (size_t)l * NG * NIS * NPS;
    for (int it = gw; it < NG * 16; it += NGW) {
        const int g = it >> 4, tau = it & 15;
        const SsmPar q = ssm_par(ap, l, g, lane);
        float fr_, fi_, tr_, ti_; ssm_f(q, fr_, fi_); ssm_apow(q, (float)tau, tr_, ti_);
        const float Er = tr_ * fr_ - ti_ * fi_, Ei = tr_ * fi_ + ti_ * fr_;
        float acc[4] = {0.f, 0.f, 0.f, 0.f};
#pragma unroll 2
        for (int p = 0; p < NPS; ++p) {
            const float er = __builtin_bit_cast(float, __builtin_amdgcn_readlane(__builtin_bit_cast(int, Er), p)), ei = __builtin_bit_cast(float, __builtin_amdgcn_readlane(__builtin_bit_cast(int, Ei), p));
#pragma unroll
            for (int k = 0; k < 4; ++k) { const int e = lane + 64 * k, o = e >> 4, i = e & 15;
                const float cr = cre[(size_t)(g * NIS + o) * NPS + p], ci = cim[(size_t)(g * NIS + o) * NPS + p], zr = cr * er - ci * ei, zi = cr * ei + ci * er;
                acc[k] += zr * bre[(size_t)(g * NPS + p) * NIS + i] - zi * bim[(size_t)(g * NPS + p) * NIS + i]; }
        }
#pragma unroll
        for (int k = 0; k < 4; ++k) Ktab[(size_t)(g * 16 + tau) * 256 + lane + 64 * k] = acc[k];
    }
}
__device__ __forceinline__ void ph_ssm_prep2(KArgsP ap, int l, long gtid, long NT) {
    const float* Ktab = (const float*)(ap->ws + WS_KTAB); bf16* BtY = (bf16*)(ap->ws + WS_BTY); bf16* BtS = (bf16*)(ap->ws + WS_BTS);
    const float* bre = ap->in[13] + (size_t)l * NG * NPS * NIS; const float* bim = ap->in[14] + (size_t)l * NG * NPS * NIS;
    const float* cre = ap->in[15] + (size_t)l * NG * NIS * NPS; const float* cim = ap->in[16] + (size_t)l * NG * NIS * NPS; const float* dsk = ap->in[17] + (size_t)l * DS;
    constexpr long NY = (long)NG * 256 * 48, NS = (long)NG * 256 * 32;
    for (long it = gtid; it < NY + NS; it += NT) {
        float v[8];
        if (it < NY) {
            const int g = (int)(it / (256 * 48)), rem = (int)(it % (256 * 48)), n = rem / 48, k0 = (rem % 48) * 8, j = n >> 4, o = n & 15;
            if (k0 < 256) { const int s = k0 >> 4, i0 = k0 & 15;
#pragma unroll
                for (int e = 0; e < 8; ++e) { float x = 0.f; if (s <= j) x = Ktab[(size_t)(g * 16 + (j - s)) * 256 + o * 16 + i0 + e]; if (s == j && i0 + e == o) x += dsk[g * NIS + o]; v[e] = x; }
            } else { const int kk = k0 - 256;
#pragma unroll
                for (int e = 0; e < 8; ++e) { const int p = (kk + e) >> 1; const bool im = (e & 1) != 0; const SsmPar q = ssm_par(ap, l, g, p); float pr, pi_; ssm_apow(q, (float)(j + 1), pr, pi_);
                    const float cr = cre[(size_t)(g * NIS + o) * NPS + p], ci = cim[(size_t)(g * NIS + o) * NPS + p]; v[e] = im ? -(cr * pi_ + ci * pr) : (cr * pr - ci * pi_); } }
            v4u w; w.x = pk2(v[0], v[1]); w.y = pk2(v[2], v[3]); w.z = pk2(v[4], v[5]); w.w = pk2(v[6], v[7]);
            *(GAS v4u*)(BtY + ((size_t)g * 256 + n) * 384 + k0) = w;
        } else {
            const long r2 = it - NY; const int g = (int)(r2 / (256 * 32)), rem = (int)(r2 % (256 * 32)), n = rem / 32, k0 = (rem % 32) * 8;
            if (n < 128) { const int p = n >> 1, s = k0 >> 4, i0 = k0 & 15; const bool im = (n & 1) != 0;
                const SsmPar q = ssm_par(ap, l, g, p); float fr_, fi_, tr_, ti_; ssm_f(q, fr_, fi_); ssm_apow(q, (float)(15 - s), tr_, ti_);
                const float Er = tr_ * fr_ - ti_ * fi_, Ei = tr_ * fi_ + ti_ * fr_;
#pragma unroll
                for (int e = 0; e < 8; ++e) { const float br = bre[(size_t)(g * NPS + p) * NIS + i0 + e], bi = bim[(size_t)(g * NPS + p) * NIS + i0 + e]; v[e] = im ? (Er * bi + Ei * br) : (Er * br - Ei * bi); }
            } else {
#pragma unroll
                for (int e = 0; e < 8; ++e) v[e] = 0.f; }
            v4u w; w.x = pk2(v[0], v[1]); w.y = pk2(v[2], v[3]); w.z = pk2(v[4], v[5]); w.w = pk2(v[6], v[7]);
            *(GAS v4u*)(BtS + ((size_t)g * 256 + n) * 256 + k0) = w;
        }
    }
}
__device__ __forceinline__ void ssm_scan_unit(KArgsP ap, LAS unsigned char* lds, int l, int g, int b, int par, int wave, int lane) {
    const SsmPar q = ssm_par(ap, l, g, lane); float cr, ci, dr, di; ssm_apow(q, 16.0f, cr, ci); ssm_apow(q, 256.0f, dr, di);
    const unsigned* Sp = (const unsigned*)(ap->ws + WS_S) + ((size_t)g * 2048 + b * 128 + 16 * wave) * 64 + lane;
    unsigned* Up = (unsigned*)((bf16*)(ap->ws + WS_UCAT) + ((size_t)g * 2048 + b * 128 + 16 * wave) * 384 + 256) + lane;
    unsigned sv[16];
#pragma unroll
    for (int j = 0; j < 16; ++j) sv[j] = Sp[(size_t)j * 64];
    float tr = 0.f, ti = 0.f;
#pragma unroll
    for (int j = 0; j < 16; ++j) { const float nr = cr * tr - ci * ti + pg8::bf_lo(sv[j]), ni = cr * ti + ci * tr + pg8::bf_hi(sv[j]); tr = nr; ti = ni; }
    LAS float* T = (LAS float*)(lds + par * 4096);
    T[wave * 128 + lane] = tr; T[wave * 128 + 64 + lane] = ti;
    __syncthreads();
    float hr = 0.f, hi = 0.f;
    for (int v = 0; v < wave; ++v) { const float xr = T[v * 128 + lane], xi = T[v * 128 + 64 + lane]; const float nr = dr * hr - di * hi + xr, ni = dr * hi + di * hr + xi; hr = nr; hi = ni; }
#pragma unroll
    for (int j = 0; j < 16; ++j) {
        Up[(size_t)j * 192] = pg8::cvt_pk_bf16(hr, hi);
        const float nr = cr * hr - ci * hi + pg8::bf_lo(sv[j]), ni = cr * hi + ci * hr + pg8::bf_hi(sv[j]); hr = nr; hi = ni;
    }
}
__device__ __forceinline__ void ph_ssm_scan(KArgsP ap, LAS unsigned char* lds, int l, int vcu, int G, int wave, int lane) {
    int par = 0;
    for (int u = vcu; u < NB * NG; u += G) { ssm_scan_unit(ap, lds, l, u % NG, u / NG, par, wave, lane); par ^= 1; }
}
constexpr int RTAB_OFF = LDSCTL_OFF + 4096;
template <class Sched> __device__ __forceinline__ pg8::RstdTab build_rstd_tab(LAS unsigned char* lds, const Sched& S, const float* ssq, int tid) {
    pg8::RstdTab R; R.tab = (const LAS float*)(lds + RTAB_OFF); R.ssq = ssq; R.p0 = R.p1 = R.p2 = R.p3 = -1;
    int np = 0; pg8::Unit u;
    for (int i = 0; S.next(i, u); ++i) if (u.pm != R.p0 && u.pm != R.p1 && u.pm != R.p2 && u.pm != R.p3) { if (np == 0) R.p0 = u.pm; else if (np == 1) R.p1 = u.pm; else if (np == 2) R.p2 = u.pm; else if (np == 3) R.p3 = u.pm; ++np; }
    LAS float* tab = (LAS float*)(lds + RTAB_OFF);
#pragma unroll
    for (int pass = 0; pass < 2; ++pass) { const int k = 2 * pass + (tid >> 8); const int pm = (k == 0) ? R.p0 : (k == 1) ? R.p1 : (k == 2) ? R.p2 : R.p3;
        if (pm >= 0) { const GAS f32x4* sp = (const GAS f32x4*)(ssq + ((size_t)pm * 256 + (tid & 255)) * 32); float sm = 0.f;
#pragma unroll
            for (int j = 0; j < 8; ++j) { const f32x4 v = sp[j]; sm += (v.x + v.y) + (v.z + v.w); }
            tab[k * 256 + (tid & 255)] = __builtin_amdgcn_rsqf(sm * (1.0f / DM) + EPS); } }
    __syncthreads();
    return R;
}
#ifndef MK_PER_PHASE
#define MK_PER_PHASE 0
#endif
#define PH_LOCALS \
    KArgsP ap = fresh_args(); \
    int tid = threadIdx.x; asm volatile("" : "+v"(tid)); \
    const int lane = tid & 63, wave = __builtin_amdgcn_readfirstlane(tid >> 6); \
    int G = gridDim.x, bx = __builtin_amdgcn_readfirstlane(((volatile LAS int*)(lds + MISC_OFF))[12]); asm volatile("" : "+s"(G), "+s"(bx)); \
    const int vcu = (G % 8 == 0) ? (bx % 8) * (G / 8) + bx / 8 : bx, gw = vcu * NWAVES + wave, NGW = G * NWAVES; \
    unsigned char* const ws = ap->ws; (void)lane; (void)gw; (void)NGW; (void)ws; (void)vcu
__global__ void __launch_bounds__(NTHR, 2) fwd_kernel(Args a) {
    extern __shared__ __attribute__((aligned(16))) unsigned char lds_raw[];
    LAS unsigned char* lds = (LAS unsigned char*)lds_raw;
    for (int u = threadIdx.x; u < (LDS_BYTES - LDSCTL_OFF) / 4; u += NTHR) ((LAS unsigned*)(lds + LDSCTL_OFF))[u] = 0u;
    __syncthreads();
    (void)xcd_barrier_post((unsigned*)(fresh_args()->ws + WS_CTL) + CW_BAR, (volatile LAS unsigned*)(lds + MISC_OFF) + 8);
    if (threadIdx.x == 0) ((volatile LAS int*)(lds + MISC_OFF))[12] = (int)blockIdx.x;
    __syncthreads();
    const int lo = a.ph_lo, hi = a.ph_hi;
#define IN(k) (lo <= (k) && (k) < hi)
#define SEAM(k) do { if (IN(k) && IN((k) + 1)) { XcdBarrier b_; b_.bar = (unsigned*)(fresh_args()->ws + WS_CTL) + CW_BAR; b_.x = xb_xcc_id(); b_.st = (volatile LAS unsigned*)(lds + MISC_OFF) + 8; xcd_barrier(b_); } } while (0)
#define GEMM_PHASE(EpiT, Eobj, Aptr, Bptr, Nv, Kv) do { pg8::Gemm g_{(const pg8::bf16_t*)(Aptr), (const pg8::bf16_t*)(Bptr), MR, (Nv), (Kv), (Kv), (Kv), nullptr, nullptr}; pg8::StaticOrder S_; S_.init(MR, (Nv), G, bx); \
        pg8::gemm_phase<EpiT, pg8::StaticOrder, true, true>(lds, g_, S_, Eobj); } while (0)
#define SEAM_L(k) do { if (IN(k) && IN((k) + 1)) { XcdBarrier b_; b_.bar = (unsigned*)(fresh_args()->ws + WS_CTL) + CW_BAR; b_.x = xb_xcc_id(); b_.st = (volatile LAS unsigned*)(lds + MISC_OFF) + 8; \
        if (b_.st[2]) xcd_barrier_local(b_); else xcd_barrier(b_); } } while (0)
#define WSP(T, off) ((T*)(ws + (off)))

    if (IN(0)) { PH_LOCALS; ph_convert(ap, lds, 0, gw, NGW, wave, lane); ph_ssm_prep1(ap, 0, gw, NGW, lane); ph_xprep(ap->in[0], WSP(bf16, WS_XB), WSP(float, WS_RSTD), gw, NGW, lane); }
    SEAM(0);
    { volatile LAS unsigned* st_ = (volatile LAS unsigned*)(lds + MISC_OFF) + 8; if (threadIdx.x == 0 && st_[2]) ((volatile LAS int*)(lds + MISC_OFF))[12] = (int)(st_[3] * 8u + xb_xcc_id()); __syncthreads(); }
    for (int l = 0; l < NL; ++l) {
        const int p0 = 1 + PH_PER_LAYER * l;
        if (IN(p0 + 0)) { PH_LOCALS; { pg8::StaticOrder S0_; S0_.init(MR, NIN, G, bx); const pg8::RstdTab rt_ = build_rstd_tab(lds, S0_, WSP(float, WS_RSTD), tid);
              pg8::EpiWin E{WSP(pg8::bf16_t, WS_PROJ), WSP(pg8::bf16_t, WS_UCAT), rt_, ap->in[3] + l * 64, ap->in[4] + l * 64, QSCALE}; GEMM_PHASE(pg8::EpiWin, E, ws + WS_XB, ws + WS_WIN, NIN, DM); }

                                    ph_ssm_prep2(ap, l, (long)vcu * NTHR + tid, (long)G * NTHR); }
        SEAM(p0 + 0);
        if (IN(p0 + 1)) { PH_LOCALS;
            ph_attn_mfma(ap, lds, l, vcu, G, wave, lane);
            VM_WAIT(); __syncthreads();
            { pg8::Gemm g_{(const pg8::bf16_t*)(ws + WS_UCAT), (const pg8::bf16_t*)(ws + WS_BTS), NG * 2048, 256, 256, 384, 256, nullptr, nullptr}; pg8::GroupOrder S_{NG * 8, G, bx, 8}; pg8::EpiSsmS E{WSP(pg8::bf16_t, WS_S)};
              pg8::gemm_phase<pg8::EpiSsmS, pg8::GroupOrder, true, true>(lds, g_, S_, E); }
            VM_WAIT(); __syncthreads();
            { int par = 0; for (int L = bx; L < NG * 8; L += G) { ssm_scan_unit(ap, lds, l, L >> 3, 2 * (L & 7), par, wave, lane); ssm_scan_unit(ap, lds, l, L >> 3, 2 * (L & 7) + 1, par ^ 1, wave, lane); } }
            VM_WAIT(); __syncthreads();
            { pg8::Gemm g_{(const pg8::bf16_t*)(ws + WS_UCAT), (const pg8::bf16_t*)(ws + WS_BTY), NG * 2048, 256, 384, 384, 384, nullptr, nullptr}; pg8::GroupOrder S_{NG * 8, G, bx, 8}; pg8::EpiSsmY E{WSP(bf16, WS_YG)};
              pg8::gemm_phase<pg8::EpiSsmY, pg8::GroupOrder, true, true>(lds, g_, S_, E); }
        }
        SEAM_L(p0 + 1);
        if (IN(p0 + 2)) { PH_LOCALS; pg8::EpiGlu E{WSP(bf16, WS_Y2), WSP(bf16, WS_YG), DS, ap->in[19] + (size_t)l * DS}; GEMM_PHASE(pg8::EpiGlu, E, ws + WS_YG, ws + WS_WGLU, DS, DS); }
        SEAM_L(p0 + 2);
        if (IN(p0 + 3)) { PH_LOCALS; pg8::Gemm g_{(const pg8::bf16_t*)(ws + WS_ON), (const pg8::bf16_t*)(ws + WS_WBA), MR, DM, DS, DS, DS, (const pg8::bf16_t*)(ws + WS_Y2), (const pg8::bf16_t*)(ws + WS_WBS)};
            pg8::TwoSegOrder S_; S_.base.init(MR, DM, G, bx); pg8::EpiGateF E{WSP(pg8::bf16_t, WS_MIX), DM, (const unsigned char*)(WSP(pg8::bf16_t, WS_PROJ) + OFF_GA), NIN * 2};
            pg8::gemm_phase<pg8::EpiGateF, pg8::TwoSegOrder, true, true>(lds, g_, S_, E); }
        SEAM_L(p0 + 3);
        if (IN(p0 + 4)) { PH_LOCALS; pg8::EpiResid E{WSP(pg8::bf16_t, WS_XB), WSP(float, WS_RSTD), nullptr}; GEMM_PHASE(pg8::EpiResid, E, ws + WS_MIX, ws + WS_WOUT, DM, DM);
        }
        SEAM(p0 + 4);
        if (IN(p0 + 5)) { PH_LOCALS; pg8::StaticOrder S0_; S0_.init(MR, NUP, G, bx); const pg8::RstdTab rt_ = build_rstd_tab(lds, S0_, WSP(float, WS_RSTD), tid);
            pg8::EpiUpConv E{WSP(pg8::bf16_t, WS_G), WSP(pg8::bf16_t, WS_RAW), rt_, ap->in[25] + (size_t)l * 3 * NUP, ap->in[26] + (size_t)l * NUP}; GEMM_PHASE(pg8::EpiUpConv, E, ws + WS_XB, ws + WS_WUP, NUP, DM);
            { const int nwg_ = (MR / 256) * (NUP / 256), rem_ = nwg_ % G; if (rem_ != 0 && bx >= rem_ && l + 1 < NL) ph_convert(ap, lds, l + 1, (bx - rem_) * NWAVES + wave, (G - rem_) * NWAVES, wave, lane, 0, CONV_I_IN); } }
        SEAM_L(p0 + 5);
        if (IN(p0 + 6)) { PH_LOCALS; ph_conv_fix(ap, l, vcu, G, tid); }
        SEAM_L(p0 + 6);
        if (IN(p0 + 7)) { PH_LOCALS; pg8::EpiResid E{WSP(pg8::bf16_t, WS_XB), WSP(float, WS_RSTD), (l == NL - 1) ? ap->out : nullptr}; GEMM_PHASE(pg8::EpiResid, E, ws + WS_G, ws + WS_WDN, DM, DFF); }
        SEAM(p0 + 7);
        if (IN(p0 + 8) && l + 1 < NL) { PH_LOCALS; ph_convert(ap, lds, l + 1, gw, NGW, wave, lane, (((MR / 256) * (NUP / 256)) % G != 0) ? CONV_I_IN : 0); ph_ssm_prep1(ap, l + 1, gw, NGW, lane); }
        SEAM(p0 + 8);
    }
#undef IN
#undef SEAM
#undef GEMM_PHASE
}

extern "C" void kernel_launch(void* const* d_in, const int* in_sizes, int n_in, void* d_out, int out_size, void* d_ws, size_t ws_size, hipStream_t stream) {
    static int grid = 0;
    if (grid == 0) {
        if (n_in != 28 || in_sizes[0] != MR * DM || out_size != MR * DM || ws_size < WS_END) { fprintf(stderr, "kernel_launch: unexpected shapes / workspace (n_in %d, ws %zu, need %zu); nothing launched\n", n_in, ws_size, (size_t)WS_END); grid = -1; return; }
        int dev = 0, cus = 0, per_cu = 0;
        if (hipGetDevice(&dev) != hipSuccess || hipDeviceGetAttribute(&cus, hipDeviceAttributeMultiprocessorCount, dev) != hipSuccess) { grid = -1; return; }
        if (hipFuncSetAttribute((const void*)fwd_kernel, hipFuncAttributeMaxDynamicSharedMemorySize, LDS_BYTES) != hipSuccess) { fprintf(stderr, "kernel_launch: hipFuncSetAttribute failed\n"); grid = -1; return; }
        if (hipOccupancyMaxActiveBlocksPerMultiprocessor(&per_cu, (const void*)fwd_kernel, NTHR, LDS_BYTES) != hipSuccess || per_cu < 1) { fprintf(stderr, "kernel_launch: occupancy query says %d\n", per_cu); }
        (void)hipGetLastError();
        grid = cus;
    }
    if (grid < 0) return;
    if (hipMemsetAsync((char*)d_ws + WS_CTL, 0, CTL_ZERO_BYTES, stream) != hipSuccess) return;
    Args a{};
    for (int i = 0; i < 28; ++i) a.in[i] = (const float*)d_in[i];
    a.out = (float*)d_out; a.ws = (unsigned char*)d_ws;
#if MK_PER_PHASE
    for (int ph = 0; ph < N_PHASES - 1; ++ph) { a.ph_lo = ph; a.ph_hi = ph + 1; hipLaunchKernelGGL(fwd_kernel, dim3(grid), dim3(NTHR), LDS_BYTES, stream, a); }
#else
    a.ph_lo = 0; a.ph_hi = N_PHASES;
    hipLaunchKernelGGL(fwd_kernel, dim3(grid), dim3(NTHR), LDS_BYTES, stream, a);
#endif
    const hipError_t le = hipPeekAtLastError();
    if (le != hipSuccess) fprintf(stderr, "kernel_launch: launch failed: %s\n", hipGetErrorName(le));
}
```

```cpp
#include <hip/hip_runtime.h>
#include <cstdio>
#include <cstdint>
namespace pg8 {
#define PG8_LAS __attribute__((address_space(3)))
typedef unsigned short bf16_t;
typedef short bf16x8 __attribute__((ext_vector_type(8)));
typedef float f32x4 __attribute__((ext_vector_type(4)));
typedef unsigned u32x4 __attribute__((ext_vector_type(4)));
constexpr int BM = 256, BK = 64, HALF = 128, HTB = HALF * BK * 2  , STAGE_BYTES = 8 * HTB, NXCD = 8, WGM = 8;

__host__ __device__ __forceinline__ int lds_byte(int r, int c) { const int st = (r >> 4) * 2 + (c >> 5), rr = r & 15, cc = c & 31, ob = rr * 64 + cc * 2; return st * 1024 + (ob ^ (((ob >> 9) & 1) << 5)); }
__host__ __device__ __forceinline__ void stage_rc(int b, int& R, int& C) { const int st = b / 1024, sb = b % 1024, swz = sb ^ (((sb >> 9) & 1) << 5); R = (st >> 1) * 16 + swz / 64; C = (st & 1) * 32 + (swz % 64) / 2; }
__host__ __device__ __forceinline__ int perm32(int rho) { const int n = rho >> 4, i = rho & 15; return 8 * (i >> 2) + 4 * n + (i & 3); }

struct Unit { int pm, pn, seg; };
struct Gemm { const bf16_t* A; const bf16_t* Bt; int M, N, K, lda, ldb; const bf16_t* A2; const bf16_t* Bt2; };

struct StaticOrder {
    int nM, nN, nwg, G, c;
    __host__ __device__ void init(int M, int N, int G_, int c_) { nM = M / BM; nN = N / BM; nwg = nM * nN; G = G_; c = c_; }
    __host__ __device__ bool next(int i, Unit& u) const {
        const long L = (long)i * G + c; if (L >= nwg) return false;
        int wgid = (int)L; { const int q = nwg / NXCD, r = nwg % NXCD, xcd = wgid % NXCD, off = wgid / NXCD; wgid = (xcd < r ? xcd * (q + 1) : r * (q + 1) + (xcd - r) * q) + off; }
        const int nig = WGM * nN, gid = wgid / nig, fm = gid * WGM, gsz = (nM - fm) < WGM ? (nM - fm) : WGM;
        u.pm = fm + ((wgid % nig) % gsz); u.pn = (wgid % nig) / gsz; u.seg = 0; return true;
    }
    __device__ __forceinline__ void a_ready(const Unit&) const {}
    __device__ __forceinline__ void done(const Unit&) const {}
};

__device__ __forceinline__ unsigned cvt_pk_bf16(float lo, float hi) { unsigned r; asm volatile("v_cvt_pk_bf16_f32 %0, %1, %2" : "=v"(r) : "v"(lo), "v"(hi)); return r; }
typedef float f32x2 __attribute__((ext_vector_type(2)));
__device__ __forceinline__ f32x2 gelu_pk(f32x2 v) {
    const f32x2 av = __builtin_elementwise_abs(v), d = av * 0.2316418882f + 1.0f;
    f32x2 t; t.x = __builtin_amdgcn_rcpf(d.x); t.y = __builtin_amdgcn_rcpf(d.y);
    f32x2 q = t * 0.5307027145f + (-0.7265760135f); q = q * t + 0.7107068705f; q = q * t + (-0.142248368f); q = q * t + 0.127414796f; q = q * t;
    const f32x2 s = (v * v) * (-0.72134752044f);
    f32x2 e; e.x = __builtin_amdgcn_exp2f(s.x); e.y = __builtin_amdgcn_exp2f(s.y);
    const f32x2 m = v * (q * e), r = v - m;
    f32x2 o; o.x = v.x < 0.f ? m.x : r.x; o.y = v.y < 0.f ? m.y : r.y; return o;
}

__device__ __forceinline__ float bf_lo(unsigned w) { return __uint_as_float(w << 16); }
__device__ __forceinline__ float bf_hi(unsigned w) { return __uint_as_float(w & 0xffff0000u); }
__device__ __forceinline__ float sigm(float z) { return __builtin_amdgcn_rcpf(1.0f + __builtin_amdgcn_exp2f(-1.4426950408889634f * z)); }
__device__ __forceinline__ f32x4 gelu_mul4(f32x4 x, f32x4 v) {
    const f32x4 t = x * x, w = t * (-2.302208198f * 0.044715f) + (-2.302208198f), z = x * w;
    f32x4 e; e[0] = __builtin_amdgcn_exp2f(z[0]); e[1] = __builtin_amdgcn_exp2f(z[1]); e[2] = __builtin_amdgcn_exp2f(z[2]); e[3] = __builtin_amdgcn_exp2f(z[3]);
    const f32x4 d = e + 1.0f; f32x4 r; r[0] = __builtin_amdgcn_rcpf(d[0]); r[1] = __builtin_amdgcn_rcpf(d[1]); r[2] = __builtin_amdgcn_rcpf(d[2]); r[3] = __builtin_amdgcn_rcpf(d[3]);
    return (x * v) * r;
}
__device__ __forceinline__ float gelu_t(float x) { const float u = x * (1.0f + 0.044715f * x * x); return x * __builtin_amdgcn_rcpf(1.0f + __builtin_amdgcn_exp2f(-2.302208198f * u)); }

__device__ __forceinline__ float sum_fq4(float v) {
    { auto r = __builtin_amdgcn_permlane16_swap(__float_as_uint(v), __float_as_uint(v), false, false); v = __uint_as_float(r[0]) + __uint_as_float(r[1]); }
    { auto r = __builtin_amdgcn_permlane32_swap(__float_as_uint(v), __float_as_uint(v), false, false); v = __uint_as_float(r[0]) + __uint_as_float(r[1]); }
    return v;
}
__device__ __forceinline__ float row_rstd(const float* ssq, int row, int fq) {
    const f32x4 a = *(const f32x4*)(ssq + (size_t)row * 32 + 8 * fq), b = *(const f32x4*)(ssq + (size_t)row * 32 + 8 * fq + 4);
    float s = ((a[0] + a[1]) + (a[2] + a[3])) + ((b[0] + b[1]) + (b[2] + b[3]));
    s = sum_fq4(s);
    return __builtin_amdgcn_rsqf(s * (1.0f / 2048.0f) + 1e-6f);
}
struct RstdTab { const PG8_LAS float* tab; int p0, p1, p2, p3; const float* ssq;
    __device__ __forceinline__ const PG8_LAS float* base(int pm) const { return (pm == p0) ? tab : (pm == p1) ? tab + 256 : (pm == p2) ? tab + 512 : (pm == p3) ? tab + 768 : (const PG8_LAS float*)nullptr; }
    __device__ __forceinline__ float get(const PG8_LAS float* tb, int row, int fq) const { return tb ? tb[row & 255] : row_rstd(ssq, row, fq); }
};
struct EpiGlu { static constexpr bool PERM = true, AFTER_DRAIN = false, ROWMAP = false, TWOSEG = false;
    bf16_t* O; const bf16_t* Y; int ld; const float* bias;
    __device__ __forceinline__ void operator()(const f32x4 (&acc)[2][2][4][2], const Unit& u, int wr, int wc, int fr, int fq) const {
        const int row0 = u.pm * BM + wr * 64 + fr, col0 = u.pn * BM + wc * 32 + 8 * fq;
        f32x4 bv[2][2];
#pragma unroll
        for (int bj = 0; bj < 2; ++bj)
#pragma unroll
            for (int n = 0; n < 2; ++n) bv[bj][n] = *(const f32x4*)(bias + col0 + bj * HALF + 4 * n);
#pragma unroll
        for (int ai = 0; ai < 2; ++ai) {
            u32x4 yv[4][2];
#pragma unroll
            for (int m = 0; m < 4; ++m)
#pragma unroll
                for (int bj = 0; bj < 2; ++bj) yv[m][bj] = *(const u32x4*)(Y + (size_t)(row0 + ai * HALF + m * 16) * ld + col0 + bj * HALF);
            asm volatile("" ::: "memory");
#pragma unroll
            for (int m = 0; m < 4; ++m) { const size_t off = (size_t)(row0 + ai * HALF + m * 16) * ld + col0;
#pragma unroll
                for (int bj = 0; bj < 2; ++bj) { const f32x4 z0 = acc[ai][bj][m][0] + bv[bj][0], z1 = acc[ai][bj][m][1] + bv[bj][1];
                    const u32x4 y = yv[m][bj];
                    u32x4 w; w.x = cvt_pk_bf16(bf_lo(y.x) * sigm(z0[0]), bf_hi(y.x) * sigm(z0[1])); w.y = cvt_pk_bf16(bf_lo(y.y) * sigm(z0[2]), bf_hi(y.y) * sigm(z0[3]));
                    w.z = cvt_pk_bf16(bf_lo(y.z) * sigm(z1[0]), bf_hi(y.z) * sigm(z1[1])); w.w = cvt_pk_bf16(bf_lo(y.w) * sigm(z1[2]), bf_hi(y.w) * sigm(z1[3]));
                    *(u32x4*)(O + off + bj * HALF) = w; } }
            asm volatile("" ::: "memory");
        }
    }
};
struct EpiResid { static constexpr bool PERM = true, AFTER_DRAIN = false, ROWMAP = false, TWOSEG = false;
    bf16_t* XB; float* ssq; float* OUT;
    __device__ __forceinline__ void operator()(const f32x4 (&acc)[2][2][4][2], const Unit& u, int wr, int wc, int fr, int fq) const {
        const int row0 = u.pm * BM + wr * 64 + fr, col0 = u.pn * BM + wc * 32 + 8 * fq;
#pragma unroll
        for (int ai = 0; ai < 2; ++ai)
#pragma unroll
        for (int mh = 0; mh < 2; ++mh) {
            u32x4 hv[2][2];
#pragma unroll
            for (int m2 = 0; m2 < 2; ++m2)
#pragma unroll
                for (int bj = 0; bj < 2; ++bj) { const size_t off = (size_t)(row0 + ai * HALF + (2 * mh + m2) * 16) * 2048 + col0 + bj * HALF; hv[m2][bj] = *(const u32x4*)(XB + off); }
            asm volatile("" ::: "memory");
            float ssv[2];
#pragma unroll
            for (int m2 = 0; m2 < 2; ++m2) { const int m = 2 * mh + m2, row = row0 + ai * HALF + m * 16; float ss = 0.f;
#pragma unroll
                for (int bj = 0; bj < 2; ++bj) { const size_t off = (size_t)row * 2048 + col0 + bj * HALF; const u32x4 h = hv[m2][bj];
                    const f32x4 x0 = (f32x4){bf_lo(h.x), bf_hi(h.x), bf_lo(h.y), bf_hi(h.y)} + acc[ai][bj][m][0];
                    const f32x4 x1 = (f32x4){bf_lo(h.z), bf_hi(h.z), bf_lo(h.w), bf_hi(h.w)} + acc[ai][bj][m][1];
                    ss += ((x0[0] * x0[0] + x0[1] * x0[1]) + (x0[2] * x0[2] + x0[3] * x0[3])) + ((x1[0] * x1[0] + x1[1] * x1[1]) + (x1[2] * x1[2] + x1[3] * x1[3]));
                    if (OUT) { *(f32x4*)(OUT + off) = x0; *(f32x4*)(OUT + off + 4) = x1; }
                    else { u32x4 w; w.x = cvt_pk_bf16(x0[0], x0[1]); w.y = cvt_pk_bf16(x0[2], x0[3]); w.z = cvt_pk_bf16(x1[0], x1[1]); w.w = cvt_pk_bf16(x1[2], x1[3]);
                        *(u32x4*)(XB + off) = w; } }
                ssv[m2] = ss; }
#pragma unroll
            for (int m2 = 0; m2 < 2; ++m2) { float ss = sum_fq4(ssv[m2]);
                if (fq == 0) ssq[(size_t)(row0 + ai * HALF + (2 * mh + m2) * 16) * 32 + 4 * u.pn + wc] = ss; }
            asm volatile("" ::: "memory");
        }
    }
};
struct GroupOrder {
    int nwg, G, c, per;
    __device__ __forceinline__ bool next(int i, Unit& u) const { const long L = (long)i * G + c; if (L >= nwg) return false; u.pm = (int)L; u.pn = (int)L / per; u.seg = 0; return true; }
    __device__ __forceinline__ void a_ready(const Unit&) const {}
    __device__ __forceinline__ void done(const Unit&) const {}
};
struct EpiSsmS { static constexpr bool PERM = true, AFTER_DRAIN = false, ROWMAP = false, TWOSEG = false;
    bf16_t* S;
    __device__ __forceinline__ void operator()(const f32x4 (&acc)[2][2][4][2], const Unit& u, int wr, int wc, int fr, int fq) const {
        const int row0 = u.pm * BM + wr * 64 + fr, col0 = wc * 32 + 8 * fq;
#pragma unroll
        for (int ai = 0; ai < 2; ++ai)
#pragma unroll
            for (int m = 0; m < 4; ++m) { const f32x4 a0 = acc[ai][0][m][0], a1 = acc[ai][0][m][1];
                u32x4 w; w.x = cvt_pk_bf16(a0[0], a0[1]); w.y = cvt_pk_bf16(a0[2], a0[3]); w.z = cvt_pk_bf16(a1[0], a1[1]); w.w = cvt_pk_bf16(a1[2], a1[3]);
                *(u32x4*)(S + (size_t)(row0 + ai * HALF + m * 16) * 128 + col0) = w; }
    }
};
struct EpiSsmY { static constexpr bool PERM = true, AFTER_DRAIN = false, ROWMAP = false, TWOSEG = false;
    bf16_t* Y;
    __device__ __forceinline__ void operator()(const f32x4 (&acc)[2][2][4][2], const Unit& u, int wr, int wc, int fr, int fq) const {
        const int g = u.pn, row0 = u.pm * BM - g * 2048 + wr * 64 + fr, col0 = wc * 32 + 8 * fq;
#pragma unroll
        for (int ai = 0; ai < 2; ++ai)
#pragma unroll
            for (int m = 0; m < 4; ++m) { const int R = row0 + ai * HALF + m * 16;
#pragma unroll
                for (int bj = 0; bj < 2; ++bj) { const int col = col0 + bj * HALF, j = col >> 4, o8 = col & 8; const f32x4 a0 = acc[ai][bj][m][0], a1 = acc[ai][bj][m][1];
                    u32x4 w; w.x = cvt_pk_bf16(gelu_t(a0[0]), gelu_t(a0[1])); w.y = cvt_pk_bf16(gelu_t(a0[2]), gelu_t(a0[3])); w.z = cvt_pk_bf16(gelu_t(a1[0]), gelu_t(a1[1])); w.w = cvt_pk_bf16(gelu_t(a1[2]), gelu_t(a1[3]));
                    *(u32x4*)(Y + (size_t)(16 * R + j) * 1024 + 16 * g + o8) = w; } }
    }
};

__device__ __forceinline__ float dpp_shr1_z(float x) { return __builtin_bit_cast(float, __builtin_amdgcn_mov_dpp(__builtin_bit_cast(int, x), 0x111, 0xF, 0xF, true)); }
__device__ __forceinline__ float dpp_shr1_w(float x, float prevblk) { const int o = __builtin_amdgcn_mov_dpp(__builtin_bit_cast(int, prevblk), 0x121, 0xF, 0xF, true);
    return __builtin_bit_cast(float, __builtin_amdgcn_update_dpp(o, __builtin_bit_cast(int, x), 0x111, 0xF, 0xF, false)); }
struct EpiUpConv { static constexpr bool PERM = true, AFTER_DRAIN = false, ROWMAP = true, TWOSEG = false;
    bf16_t* Gm; bf16_t* RAW; RstdTab rt; const float* cw; const float* cb;
    __device__ __forceinline__ void operator()(const f32x4 (&acc)[2][2][4][2], const Unit& u, int wr, int wc, int fr, int fq) const {
        constexpr int DFF = 5504, NUP = 11008;
        const int tok0 = u.pm * BM + 128 * wr + 4 * fr, f0 = u.pn * 128 + wc * 32 + 8 * fq;
        const PG8_LAS float* tb_ = rt.base(u.pm);
        float rs[2][4];
#pragma unroll
        for (int ai = 0; ai < 2; ++ai)
#pragma unroll
            for (int m = 0; m < 4; ++m) rs[ai][m] = rt.get(tb_, tok0 + 64 * ai + m, fq);
        typedef unsigned u32x2g __attribute__((ext_vector_type(2))); u32x2g gst[2][4];
#pragma unroll
        for (int n = 0; n < 2; ++n) {
            const int f = f0 + 4 * n;
            const f32x4 w0a = *(const f32x4*)(cw + f), w1a = *(const f32x4*)(cw + NUP + f), w2a = *(const f32x4*)(cw + 2 * NUP + f), cba = *(const f32x4*)(cb + f);
            const f32x4 w0v = *(const f32x4*)(cw + DFF + f), w1v = *(const f32x4*)(cw + NUP + DFF + f), w2v = *(const f32x4*)(cw + 2 * NUP + DFF + f), cbv = *(const f32x4*)(cb + DFF + f);
            f32x4 pa2 = {0.f, 0.f, 0.f, 0.f}, pa3 = pa2, pv2 = pa2, pv3 = pa2;
#pragma unroll
            for (int ai = 0; ai < 2; ++ai) {
                f32x4 pa[4], pv[4];
#pragma unroll
                for (int m = 0; m < 4; ++m) { pa[m] = acc[ai][0][m][n] * rs[ai][m]; pv[m] = acc[ai][1][m][n] * rs[ai][m]; }
                f32x4 x1a, x2a, x1v, x2v;
#pragma unroll
                for (int e = 0; e < 4; ++e) {
                    if (ai == 0) { x1a[e] = dpp_shr1_z(pa[3][e]); x2a[e] = dpp_shr1_z(pa[2][e]); x1v[e] = dpp_shr1_z(pv[3][e]); x2v[e] = dpp_shr1_z(pv[2][e]); }
                    else { x1a[e] = dpp_shr1_w(pa[3][e], pa3[e]); x2a[e] = dpp_shr1_w(pa[2][e], pa2[e]); x1v[e] = dpp_shr1_w(pv[3][e], pv3[e]); x2v[e] = dpp_shr1_w(pv[2][e], pv2[e]); } }
                { const bool first = (ai == 0) && (fr == 0), last = (ai == 1) && (fr == 15);
                  if (first || last) { bf16_t* rp = RAW + ((size_t)u.pm * 8 + 4 * wr + 2 * ai) * NUP + f;
                      const f32x4 a0 = first ? pa[0] : pa[2], a1 = first ? pa[1] : pa[3], v0 = first ? pv[0] : pv[2], v1 = first ? pv[1] : pv[3];
                      typedef unsigned u32x2 __attribute__((ext_vector_type(2)));
                      u32x2 t; t.x = cvt_pk_bf16(a0[0], a0[1]); t.y = cvt_pk_bf16(a0[2], a0[3]); *(u32x2*)(rp) = t;
                      t.x = cvt_pk_bf16(a1[0], a1[1]); t.y = cvt_pk_bf16(a1[2], a1[3]); *(u32x2*)(rp + NUP) = t;
                      t.x = cvt_pk_bf16(v0[0], v0[1]); t.y = cvt_pk_bf16(v0[2], v0[3]); *(u32x2*)(rp + DFF) = t;
                      t.x = cvt_pk_bf16(v1[0], v1[1]); t.y = cvt_pk_bf16(v1[2], v1[3]); *(u32x2*)(rp + NUP + DFF) = t; } }
#pragma unroll
                for (int m = 0; m < 4; ++m) {
                    const f32x4 s1a = (m == 0) ? x1a : pa[m - 1], s2a = (m == 0) ? x2a : (m == 1) ? x1a : pa[m - 2];
                    const f32x4 s1v = (m == 0) ? x1v : pv[m - 1], s2v = (m == 0) ? x2v : (m == 1) ? x1v : pv[m - 2];
                    const f32x4 ca = cba + w0a * s2a + w1a * s1a + w2a * pa[m], cv = cbv + w0v * s2v + w1v * s1v + w2v * pv[m];
                    typedef unsigned u32x2 __attribute__((ext_vector_type(2)));
                    const f32x4 gv_ = gelu_mul4(ca, cv); u32x2 t; t.x = cvt_pk_bf16(gv_[0], gv_[1]); t.y = cvt_pk_bf16(gv_[2], gv_[3]);
                    if (n == 0) gst[ai][m] = t;
                    else { u32x4 w4; w4.x = gst[ai][m].x; w4.y = gst[ai][m].y; w4.z = t.x; w4.w = t.y; *(u32x4*)(Gm + (size_t)(tok0 + 64 * ai + m) * DFF + f0) = w4; } }
                pa2 = pa[2]; pa3 = pa[3]; pv2 = pv[2]; pv3 = pv[3];
            }
        }
    }
};

struct EpiWin { static constexpr bool PERM = true, AFTER_DRAIN = false, ROWMAP = false, TWOSEG = false;
    bf16_t* O; bf16_t* UC; RstdTab rt; const float* qg; const float* kg; float qscale;
    __device__ __forceinline__ void operator()(const f32x4 (&acc)[2][2][4][2], const Unit& u, int wr, int wc, int fr, int fq) const {
        const int row0 = u.pm * BM + wr * 64 + fr; const PG8_LAS float* tb_ = rt.base(u.pm);
        if (u.pn < 8) {
            const float* g = (u.pn < 4) ? qg : kg; const float sc0 = (u.pn < 4) ? qscale : 1.0f;
            f32x4 gv[2][2];
#pragma unroll
            for (int bj = 0; bj < 2; ++bj)
#pragma unroll
                for (int n = 0; n < 2; ++n) gv[bj][n] = *(const f32x4*)(g + 32 * bj + 8 * fq + 4 * n) * sc0;
#pragma unroll
            for (int ai = 0; ai < 2; ++ai)
#pragma unroll
                for (int m = 0; m < 4; ++m) { const int row = row0 + ai * HALF + m * 16; const float rs = rt.get(tb_, row, fq);
                    float sa = 0.f;
#pragma unroll
                    for (int bj = 0; bj < 2; ++bj)
#pragma unroll
                        for (int n = 0; n < 2; ++n) { const f32x4 a = acc[ai][bj][m][n]; sa += (a[0] * a[0] + a[1] * a[1]) + (a[2] * a[2] + a[3] * a[3]); }
                    sa = sum_fq4(sa);
                    const float sc = rs * __builtin_amdgcn_rsqf(rs * rs * sa * (1.0f / 64.0f) + 1e-6f);
#pragma unroll
                    for (int bj = 0; bj < 2; ++bj) { const f32x4 v0 = acc[ai][bj][m][0] * sc * gv[bj][0], v1 = acc[ai][bj][m][1] * sc * gv[bj][1];
                        u32x4 w; w.x = cvt_pk_bf16(v0[0], v0[1]); w.y = cvt_pk_bf16(v0[2], v0[3]); w.z = cvt_pk_bf16(v1[0], v1[1]); w.w = cvt_pk_bf16(v1[2], v1[3]);
                        *(u32x4*)(O + (size_t)row * 8192 + u.pn * BM + 64 * wc + 32 * bj + 8 * fq) = w; } }
        } else if (u.pn >= 12 && u.pn < 16) {
#pragma unroll
            for (int ai = 0; ai < 2; ++ai)
#pragma unroll
                for (int m = 0; m < 4; ++m) { const int row = row0 + ai * HALF + m * 16; const float s = rt.get(tb_, row, fq);
#pragma unroll
                    for (int bj = 0; bj < 2; ++bj) { const f32x4 v0 = acc[ai][bj][m][0] * s, v1 = acc[ai][bj][m][1] * s;
                        u32x4 w; w.x = cvt_pk_bf16(v0[0], v0[1]); w.y = cvt_pk_bf16(v0[2], v0[3]); w.z = cvt_pk_bf16(v1[0], v1[1]); w.w = cvt_pk_bf16(v1[2], v1[3]);
                        const int c = (u.pn - 12) * BM + bj * HALF + wc * 32 + 8 * fq, g = c >> 4;
                        *(u32x4*)(UC + ((size_t)g * 2048 + (row >> 4)) * 384 + 16 * (row & 15) + (c & 15)) = w; } }
        } else if (u.pn >= 16) {
            const int c0 = (u.pn - 16) * HALF + wc * 32 + 8 * fq;
#pragma unroll
            for (int ai = 0; ai < 2; ++ai)
#pragma unroll
                for (int m = 0; m < 4; ++m) { const int row = row0 + ai * HALF + m * 16; const float s = -1.4426950408889634f * rt.get(tb_, row, fq);
                    unsigned qa[2] = {0u, 0u}, qs[2] = {0u, 0u};
#pragma unroll
                    for (int n = 0; n < 2; ++n)
#pragma unroll
                        for (int e = 0; e < 4; ++e) { const float ea = __builtin_amdgcn_exp2f(s * acc[ai][0][m][n][e]), es = __builtin_amdgcn_exp2f(s * acc[ai][1][m][n][e]);
                            const float va = __builtin_amdgcn_rcpf(1.0f + ea), vs = __builtin_amdgcn_rcpf(1.0f + es);
                            const unsigned ia = (unsigned)(va * 255.0f + 0.5f); unsigned is = (unsigned)(vs * 255.0f + 0.5f); is = is < 1u ? 1u : is;
                            qa[n] |= ia << (8 * e); qs[n] |= is << (8 * e); }
                    u32x4 w; w.x = qa[0]; w.y = qa[1]; w.z = qs[0]; w.w = qs[1];
                    *(u32x4*)((unsigned char*)(O + (size_t)row * 8192 + 4096) + (size_t)(c0 >> 3) * 16) = w; }
        } else {
            const int col0 = u.pn * BM + wc * 32 + 8 * fq;
#pragma unroll
            for (int ai = 0; ai < 2; ++ai)
#pragma unroll
                for (int m = 0; m < 4; ++m) { const int row = row0 + ai * HALF + m * 16; const float s = rt.get(tb_, row, fq); bf16_t* rowp = O + (size_t)row * 8192 + col0;
#pragma unroll
                    for (int bj = 0; bj < 2; ++bj) { const f32x4 v0 = acc[ai][bj][m][0] * s, v1 = acc[ai][bj][m][1] * s;
                        u32x4 w; w.x = cvt_pk_bf16(v0[0], v0[1]); w.y = cvt_pk_bf16(v0[2], v0[3]); w.z = cvt_pk_bf16(v1[0], v1[1]); w.w = cvt_pk_bf16(v1[2], v1[3]);
                        *(u32x4*)(rowp + bj * HALF) = w; } }
        }
    }
};


struct TwoSegOrder {
    StaticOrder base;
    __device__ __forceinline__ bool next(int i, Unit& u) const { if (!base.next(i >> 1, u)) return false; u.seg = i & 1; return true; }
    __device__ __forceinline__ void a_ready(const Unit&) const {}
    __device__ __forceinline__ void done(const Unit&) const {}
};
__device__ __forceinline__ f32x4 ub4(unsigned w) { return (f32x4){(float)(w & 0xffu), (float)((w >> 8) & 0xffu), (float)((w >> 16) & 0xffu), (float)(w >> 24)}; }
__device__ __forceinline__ f32x4 rcp4(f32x4 d) { return (f32x4){__builtin_amdgcn_rcpf(d[0]), __builtin_amdgcn_rcpf(d[1]), __builtin_amdgcn_rcpf(d[2]), __builtin_amdgcn_rcpf(d[3])}; }
struct EpiGateF { static constexpr bool PERM = true, AFTER_DRAIN = false, ROWMAP = false, TWOSEG = true;
    bf16_t* O; int ldo; const unsigned char* GT; int ldgB;
    __device__ __forceinline__ void mid(f32x4 (&acc)[2][2][4][2], const Unit& u, int wr, int wc, int fr, int fq) const {
        const int row0 = u.pm * BM + wr * 64 + fr, col0 = u.pn * BM + wc * 32 + 8 * fq;
#pragma unroll
        for (int ai = 0; ai < 2; ++ai) {
            u32x4 gv[4][2];
#pragma unroll
            for (int m = 0; m < 4; ++m)
#pragma unroll
                for (int bj = 0; bj < 2; ++bj) gv[m][bj] = *(const u32x4*)(GT + (size_t)(row0 + ai * HALF + m * 16) * ldgB + (size_t)((col0 + bj * HALF) >> 3) * 16);
#pragma unroll
            for (int m = 0; m < 4; ++m)
#pragma unroll
                for (int bj = 0; bj < 2; ++bj) { const u32x4 g = gv[m][bj];
                    acc[ai][bj][m][0] = acc[ai][bj][m][0] * (ub4(g.x) * rcp4(ub4(g.z)));
                    acc[ai][bj][m][1] = acc[ai][bj][m][1] * (ub4(g.y) * rcp4(ub4(g.w))); }
        }
    }
    __device__ __forceinline__ void operator()(const f32x4 (&acc)[2][2][4][2], const Unit& u, int wr, int wc, int fr, int fq) const {
        typedef unsigned u32x2l __attribute__((ext_vector_type(2)));
        const int row0 = u.pm * BM + wr * 64 + fr, col0 = u.pn * BM + wc * 32 + 8 * fq;
#pragma unroll
        for (int ai = 0; ai < 2; ++ai) {
            u32x2l gv[4][2];
#pragma unroll
            for (int m = 0; m < 4; ++m)
#pragma unroll
                for (int bj = 0; bj < 2; ++bj) gv[m][bj] = *(const u32x2l*)(GT + (size_t)(row0 + ai * HALF + m * 16) * ldgB + (size_t)((col0 + bj * HALF) >> 3) * 16 + 8);
            asm volatile("" ::: "memory");
#pragma unroll
            for (int m = 0; m < 4; ++m)
#pragma unroll
                for (int bj = 0; bj < 2; ++bj) { const u32x2l g = gv[m][bj]; const f32x4 a0 = acc[ai][bj][m][0] * (ub4(g.x) * (1.0f / 255.0f)), a1 = acc[ai][bj][m][1] * (ub4(g.y) * (1.0f / 255.0f));
                    u32x4 w; w.x = cvt_pk_bf16(a0[0], a0[1]); w.y = cvt_pk_bf16(a0[2], a0[3]); w.z = cvt_pk_bf16(a1[0], a1[1]); w.w = cvt_pk_bf16(a1[2], a1[3]);
                    *(u32x4*)(O + (size_t)(row0 + ai * HALF + m * 16) * ldo + col0 + bj * HALF) = w; }
            asm volatile("" ::: "memory");
        }
    }
};

template <class Epi, class Sched, bool ALIGN_EPI = false, bool SP2 = false>
__device__ __forceinline__ void gemm_phase(PG8_LAS unsigned char* lds, const Gemm g, const Sched& S, const Epi& E) {
    int tid_ = threadIdx.x; asm volatile("" : "+v"(tid_));
    const int tid = tid_, wid = __builtin_amdgcn_readfirstlane(tid >> 6), lane = tid & 63, wr = wid >> 2, wc = wid & 3, fr = lane & 15, fq = lane >> 4;
    const int K = g.K, nt = K / BK;
    unsigned voffA[2], voffB[2];
#pragma unroll
    for (int i = 0; i < 2; ++i) { int R, C; stage_rc(tid * 16 + i * 8192, R, C); const int Rb = Epi::PERM ? ((R & ~31) + perm32(R & 31)) : R;
        const int Ra = Epi::ROWMAP ? (128 * (R >> 6) + 4 * (R & 15) + ((R >> 4) & 3)) : R;
        voffA[i] = (unsigned)(Ra * g.lda + C) * 2u; voffB[i] = (unsigned)(Rb * g.ldb + C) * 2u; }
    const size_t kstep = (size_t)(BK * 2);
    const size_t hstepA = (size_t)(Epi::ROWMAP ? 64 : HALF) * g.lda * 2, hstepB = (size_t)HALF * g.ldb * 2;
    const size_t tstepA = (size_t)BM * g.lda * 2, tstepB = 2 * hstepB;
    const unsigned ldsw = (unsigned)wid * 1024u;
    const int aoff = lds_byte(wr * 64 + fr, fq * 8), boff = lds_byte(wc * 32 + fr, fq * 8);
#define PG8_SA(b, h) (((b) * 2 + (h)) * HTB)
#define PG8_SB(b, h) ((4 + (b) * 2 + (h)) * HTB)
#define PG8_STAGE(bufoff, gbase, voff) do { _Pragma("unroll") for (int _i = 0; _i < 2; ++_i) \
        __builtin_amdgcn_global_load_lds((const unsigned*)((const char*)(gbase) + (voff)[_i]), (PG8_LAS unsigned*)(lds + (bufoff) + ldsw + _i * 8192), 16, 0, 0); } while (0)
#define PG8_LDA(dst, b, h) do { _Pragma("unroll") for (int m = 0; m < 4; ++m) _Pragma("unroll") for (int k = 0; k < 2; ++k) dst[m][k] = *(const PG8_LAS bf16x8*)(lds + PG8_SA(b, h) + aoff + m * 2048 + k * 1024); } while (0)
#define PG8_LDB(dst, b, h) do { _Pragma("unroll") for (int n = 0; n < 2; ++n) _Pragma("unroll") for (int k = 0; k < 2; ++k) dst[n][k] = *(const PG8_LAS bf16x8*)(lds + PG8_SB(b, h) + boff + n * 2048 + k * 1024); } while (0)
#define PG8_MMA(ai, bj, At, Bt) do { __builtin_amdgcn_s_setprio(1); _Pragma("unroll") for (int m = 0; m < 4; ++m) _Pragma("unroll") for (int n = 0; n < 2; ++n) _Pragma("unroll") for (int k = 0; k < 2; ++k) \
        acc[ai][bj][m][n] = __builtin_amdgcn_mfma_f32_16x16x32_bf16(Bt[n][k], At[m][k], acc[ai][bj][m][n], 0, 0, 0); __builtin_amdgcn_s_setprio(0); } while (0)
#define PG8_WAIT_V(n) asm volatile("s_waitcnt vmcnt(" #n ")" ::: "memory")
#define PG8_WAIT_L(n) asm volatile("s_waitcnt lgkmcnt(" #n ")" ::: "memory")
#define PG8_BAR __builtin_amdgcn_s_barrier()
#define PG8_SCHED __builtin_amdgcn_sched_barrier(0)
    Unit cur, nxt; int ui = 0;
    if (!S.next(0, cur)) return;
    f32x4 acc[2][2][4][2];
#pragma unroll
    for (int a = 0; a < 2; ++a)
#pragma unroll
        for (int b = 0; b < 2; ++b)
#pragma unroll
            for (int m = 0; m < 4; ++m)
#pragma unroll
                for (int n = 0; n < 2; ++n) acc[a][b][m][n] = (f32x4){0.f, 0.f, 0.f, 0.f};
    bf16x8 At[4][2], B0[2][2], B1[2][2];
    const char* cA = (const char*)((Epi::TWOSEG && cur.seg) ? g.A2 : g.A) + (size_t)cur.pm * tstepA; const char* cB = (const char*)((Epi::TWOSEG && cur.seg) ? g.Bt2 : g.Bt) + (size_t)cur.pn * tstepB;
    S.a_ready(cur);
    if constexpr (SP2) {
        PG8_STAGE(PG8_SB(0, 0), cB, voffB); PG8_STAGE(PG8_SB(0, 1), cB + hstepB, voffB); PG8_STAGE(PG8_SA(0, 0), cA, voffA); PG8_STAGE(PG8_SA(0, 1), cA + hstepA, voffA);
        if (wr == 1) PG8_BAR;
        PG8_WAIT_V(2); PG8_BAR;
        PG8_STAGE(PG8_SB(1, 0), cB + kstep, voffB); PG8_STAGE(PG8_SA(1, 0), cA + kstep, voffA); PG8_STAGE(PG8_SB(1, 1), cB + hstepB + kstep, voffB);
        PG8_WAIT_V(6); PG8_BAR;
    } else {
        PG8_STAGE(PG8_SB(0, 0), cB, voffB); PG8_STAGE(PG8_SA(0, 0), cA, voffA); PG8_STAGE(PG8_SB(0, 1), cB + hstepB, voffB); PG8_STAGE(PG8_SA(0, 1), cA + hstepA, voffA);
        if (wr == 1) PG8_BAR;
        PG8_WAIT_V(4); PG8_BAR;
        PG8_STAGE(PG8_SB(1, 0), cB + kstep, voffB); PG8_STAGE(PG8_SA(1, 0), cA + kstep, voffA); PG8_STAGE(PG8_SB(1, 1), cB + hstepB + kstep, voffB);
        PG8_WAIT_V(6); PG8_BAR;
    }
    for (;;) {
        const bool has_next = S.next(ui + 1, nxt);
        const char* nA = has_next ? (const char*)((Epi::TWOSEG && nxt.seg) ? g.A2 : g.A) + (size_t)nxt.pm * tstepA : cA; const char* nB = has_next ? (const char*)((Epi::TWOSEG && nxt.seg) ? g.Bt2 : g.Bt) + (size_t)nxt.pn * tstepB : cB;
        for (int t = 0; t < nt; t += 2) {
            const bool last = (t == nt - 2);
            const char* a1 = cA + (size_t)(t + 1) * kstep;
            const char* a2 = last ? nA : cA + (size_t)(t + 2) * kstep; const char* b2 = last ? nB : cB + (size_t)(t + 2) * kstep;
            const char* a3 = a2 + kstep; const char* b3 = b2 + kstep;
            if (last && has_next) S.a_ready(nxt);
            if constexpr (SP2) {
            PG8_LDB(B0, 0, 0); PG8_LDB(B1, 0, 1); PG8_SCHED; PG8_LDA(At, 0, 0); PG8_STAGE(PG8_SA(1, 1), a1 + hstepA, voffA);
            PG8_WAIT_V(8); PG8_WAIT_L(0); PG8_BAR; PG8_MMA(0, 0, At, B0); PG8_MMA(0, 1, At, B1); PG8_BAR; PG8_SCHED;
            PG8_LDA(At, 0, 1); PG8_STAGE(PG8_SB(0, 0), b2, voffB); PG8_STAGE(PG8_SB(0, 1), b2 + hstepB, voffB); PG8_STAGE(PG8_SA(0, 0), a2, voffA);
            PG8_WAIT_V(8); PG8_WAIT_L(0); PG8_BAR; PG8_MMA(1, 0, At, B0); PG8_MMA(1, 1, At, B1); PG8_BAR; PG8_SCHED;
            PG8_LDB(B0, 1, 0); PG8_LDB(B1, 1, 1); PG8_SCHED; PG8_LDA(At, 1, 0); PG8_STAGE(PG8_SA(0, 1), a2 + hstepA, voffA);
            PG8_WAIT_V(8); PG8_WAIT_L(0); PG8_BAR; PG8_MMA(0, 0, At, B0); PG8_MMA(0, 1, At, B1); PG8_BAR; PG8_SCHED;
            PG8_LDA(At, 1, 1); PG8_STAGE(PG8_SB(1, 0), b3, voffB); PG8_STAGE(PG8_SB(1, 1), b3 + hstepB, voffB); PG8_STAGE(PG8_SA(1, 0), a3, voffA);
            PG8_WAIT_V(8); PG8_WAIT_L(0); PG8_BAR; PG8_MMA(1, 0, At, B0); PG8_MMA(1, 1, At, B1); PG8_BAR; PG8_SCHED;
            } else {
            PG8_LDB(B0, 0, 0); PG8_SCHED; PG8_LDA(At, 0, 0); PG8_STAGE(PG8_SA(1, 1), a1 + hstepA, voffA);
            PG8_WAIT_L(8); PG8_BAR; PG8_WAIT_L(0); PG8_MMA(0, 0, At, B0); PG8_BAR; PG8_SCHED;
            PG8_LDB(B1, 0, 1); PG8_STAGE(PG8_SB(0, 0), b2, voffB);
            PG8_BAR; PG8_WAIT_L(0); PG8_MMA(0, 1, At, B1); PG8_BAR;
            PG8_LDA(At, 0, 1); PG8_STAGE(PG8_SA(0, 0), a2, voffA);
            PG8_BAR; PG8_WAIT_L(0); PG8_MMA(1, 0, At, B0); PG8_BAR; PG8_SCHED;
            PG8_STAGE(PG8_SB(0, 1), b2 + hstepB, voffB);
            PG8_WAIT_V(6); PG8_BAR; PG8_MMA(1, 1, At, B1); PG8_BAR;
            PG8_LDB(B0, 1, 0); PG8_SCHED; PG8_LDA(At, 1, 0); PG8_STAGE(PG8_SA(0, 1), a2 + hstepA, voffA);
            PG8_WAIT_L(8); PG8_BAR; PG8_WAIT_L(0); PG8_MMA(0, 0, At, B0); PG8_BAR; PG8_SCHED;
            PG8_LDB(B1, 1, 1); PG8_STAGE(PG8_SB(1, 0), b3, voffB);
            PG8_BAR; PG8_WAIT_L(0); PG8_MMA(0, 1, At, B1); PG8_BAR;
            PG8_LDA(At, 1, 1); PG8_STAGE(PG8_SA(1, 0), a3, voffA);
            PG8_BAR; PG8_WAIT_L(0); PG8_MMA(1, 0, At, B0); PG8_BAR; PG8_SCHED;
            PG8_STAGE(PG8_SB(1, 1), b3 + hstepB, voffB);
            PG8_WAIT_V(6); PG8_BAR; PG8_MMA(1, 1, At, B1); PG8_BAR;
            }
        }
        if constexpr (ALIGN_EPI) { if (wr == 0) PG8_BAR; }
        const bool midseg = Epi::TWOSEG && cur.seg == 0;
        if constexpr (!Epi::AFTER_DRAIN) { if constexpr (Epi::TWOSEG) { if (midseg) E.mid(acc, cur, wr, wc, fr, fq); else { E(acc, cur, wr, wc, fr, fq); S.done(cur); } } else { E(acc, cur, wr, wc, fr, fq); S.done(cur); } }
        if (!has_next) break;
        if (!midseg)
#pragma unroll
        for (int a = 0; a < 2; ++a)
#pragma unroll
            for (int b = 0; b < 2; ++b)
#pragma unroll
                for (int m = 0; m < 4; ++m)
#pragma unroll
                    for (int n = 0; n < 2; ++n) acc[a][b][m][n] = (f32x4){0.f, 0.f, 0.f, 0.f};
        cur = nxt; cA = nA; cB = nB; ++ui;
        if constexpr (ALIGN_EPI) { if (wr == 1) PG8_BAR; }
    }
    PG8_WAIT_V(0);
    if constexpr (!ALIGN_EPI) { if (wr == 0) PG8_BAR; }
    PG8_BAR;
    if constexpr (Epi::AFTER_DRAIN) { E.fused(acc, cur, wr, wc, fr, fq, lds, wid, lane); S.done(cur); }
#undef PG8_SA
#undef PG8_SB
#undef PG8_STAGE
#undef PG8_LDA
#undef PG8_LDB
#undef PG8_MMA
#undef PG8_WAIT_V
#undef PG8_WAIT_L
#undef PG8_BAR
#undef PG8_SCHED
}
}
constexpr int NWAVES = 8, NTHR = NWAVES * 64;
constexpr int NL = 4, NB = 16, SEQ = 2048, DM = 2048, MR = NB * SEQ;
constexpr int NIN = 8192, DFF = 5504, NUP = 2 * DFF, DS = 1024, NG = 64, NPS = 64, NIS = 16, NH = 8;
constexpr int OFF_K = 1024, OFF_V = 2048, OFF_U = 3072, OFF_GA = 4096, OFF_GS = 6144;
constexpr float EPS = 1e-6f, LOG2E = 1.4426950408889634f, QSCALE = 0.125f * LOG2E;
constexpr int PH_PER_LAYER = 9, N_PHASES = 1 + NL * PH_PER_LAYER;

constexpr size_t MiB = 1u << 20;
constexpr size_t WS_CTL = 0, CTL_ZERO_BYTES = 1 * MiB;
constexpr size_t WS_WIN = 2 * MiB, WS_WGLU = 34 * MiB, WS_WBA = 36 * MiB, WS_WBS = 40 * MiB, WS_WOUT = 44 * MiB, WS_WUP = 52 * MiB, WS_WDN = 95 * MiB;
constexpr size_t WS_RSTD = 1280 * MiB;
constexpr size_t WS_XB = 120 * MiB;
constexpr size_t WS_PROJ = 248 * MiB;
constexpr size_t WS_YG = 1104 * MiB, WS_Y2 = 1284 * MiB, WS_ON = 888 * MiB;
constexpr size_t WS_MIX = 952 * MiB;
constexpr size_t WS_RAW = 248 * MiB;
constexpr size_t WS_G = 936 * MiB;
constexpr size_t WS_BTY = 1080 * MiB, WS_BTS = 1092 * MiB, WS_KTAB = 1100 * MiB;
constexpr size_t WS_S = 824 * MiB;
constexpr size_t WS_UCAT = 1168 * MiB;
constexpr size_t WS_END = 1348 * MiB;
constexpr int CW_BAR = 4096;

constexpr int RING_BYTES = 131072, LDSCTL_OFF = RING_BYTES, MISC_OFF = LDSCTL_OFF + 320, LDS_BYTES = 147456;

#define GAS __attribute__((address_space(1)))
#define LAS __attribute__((address_space(3)))
typedef unsigned short bf16;
typedef unsigned v4u __attribute__((ext_vector_type(4)));
typedef float f32x4 __attribute__((ext_vector_type(4)));
typedef short bf16x8 __attribute__((ext_vector_type(8)));
typedef GAS unsigned gu32;
typedef GAS unsigned long long gu64;
#define RLX_AGENT __ATOMIC_RELAXED, __HIP_MEMORY_SCOPE_AGENT
#define LDS_WAIT() asm volatile("s_waitcnt lgkmcnt(0)" ::: "memory")
#define VM_WAIT() asm volatile("s_waitcnt vmcnt(0)" ::: "memory")
__device__ __forceinline__ unsigned long long rt() { return __builtin_amdgcn_s_memrealtime(); }
__device__ __forceinline__ unsigned f2bf(float f) { unsigned u = __builtin_bit_cast(unsigned, f); return (u + 0x7fffu + ((u >> 16) & 1u)) >> 16; }
__device__ __forceinline__ unsigned pk2(float lo, float hi) { return f2bf(lo) | (f2bf(hi) << 16); }

#define XB_TMO      128
#define XB_XCNT(j)  (256  + 64 * (j))
#define XB_XSUB(j)  (1280 + 64 * (j))
#define XB_XGEN(j)  (2304 + 64 * (j))
#define XB_TOP      3328
#define XB_TOPGEN   3392
#define XCD_BAR_WORDS 3456
#define XB_SPIN_CAP (1u << 18)

__device__ __forceinline__ unsigned xb_ld(unsigned* p)              { return __hip_atomic_load(p, __ATOMIC_RELAXED, __HIP_MEMORY_SCOPE_AGENT); }
__device__ __forceinline__ unsigned xb_add(unsigned* p, unsigned v) { return __hip_atomic_fetch_add(p, v, __ATOMIC_RELAXED, __HIP_MEMORY_SCOPE_AGENT); }
__device__ __forceinline__ unsigned xb_xcc_id() { return (unsigned)__builtin_amdgcn_s_getreg((3 << 11) | 20) & 0xFu; }
#define XB_SPIN(cond, bar) do { unsigned _sp = 0; while (cond) { __builtin_amdgcn_s_sleep(1); \
    if ((++_sp & 255u) == 0u) { if (xb_ld(&(bar)[XB_TMO])) break; if (_sp > XB_SPIN_CAP) { atomicAdd(&(bar)[XB_TMO], 1u); break; } } } } while (0)

struct XcdBarrier {
    unsigned* bar; unsigned x;
    volatile LAS unsigned* st;
};

__device__ __forceinline__ XcdBarrier xcd_barrier_post(unsigned* bar, volatile LAS unsigned* st) {
    XcdBarrier b; b.bar = bar; b.x = xb_xcc_id(); b.st = st;
    if (threadIdx.x == 0) st[3] = xb_add(&bar[XB_XCNT(b.x)], 1u);
    return b;
}
__device__ __forceinline__ void xcd_barrier_complete(unsigned* bar, unsigned x, unsigned& nloc, unsigned& nx, unsigned& even) {
    const unsigned G = gridDim.x * gridDim.y * gridDim.z;
    unsigned sum, cnt, mine, ev, sp = 0u;
    for (;;) {
        sum = 0u; cnt = 0u; mine = 0u; ev = (G % 8u == 0u) ? 1u : 0u;
#pragma unroll
        for (unsigned j = 0; j < 16; ++j) { const unsigned c = xb_ld(&bar[XB_XCNT(j)]); sum += c; cnt += (c > 0u) ? 1u : 0u; mine = (j == x) ? c : mine; if (j < 8u && c * 8u != G) ev = 0u; }
        if (sum == G) break;
        __builtin_amdgcn_s_sleep(1);
        if ((++sp & 255u) == 0u) { if (xb_ld(&bar[XB_TMO])) break; if (sp > XB_SPIN_CAP) { atomicAdd(&bar[XB_TMO], 1u); break; } }
    }
    nloc = mine > 0u ? mine : 1u; nx = cnt > 0u ? cnt : 1u; even = (sum == G) ? ev : 0u;
}

__device__ __forceinline__ void xcd_barrier(const XcdBarrier& b) {
    asm volatile("s_waitcnt vmcnt(0)" ::: "memory");
    __syncthreads();
    if (threadIdx.x == 0) {
        unsigned* bar = b.bar;
        __builtin_amdgcn_s_waitcnt(0);
        unsigned nloc = b.st[0], nx = b.st[1];
        if (nloc == 0u) { unsigned even; xcd_barrier_complete(bar, b.x, nloc, nx, even); b.st[0] = nloc; b.st[1] = nx; b.st[2] = even; }
        const unsigned old = xb_add(&bar[XB_XSUB(b.x)], 1u);
        const unsigned gen = old / nloc;
        if (old + 1u == (gen + 1u) * nloc) {
            __builtin_amdgcn_fence(__ATOMIC_RELEASE, "agent");
            asm volatile("s_waitcnt vmcnt(0)" ::: "memory");
            const unsigned og = xb_add(&bar[XB_TOP], 1u);
            const unsigned tg = og / nx;
            if (og + 1u == (tg + 1u) * nx) xb_add(&bar[XB_TOPGEN], 1u);
            else XB_SPIN(xb_ld(&bar[XB_TOPGEN]) == tg, bar);
            __builtin_amdgcn_fence(__ATOMIC_ACQUIRE, "agent");
            xb_add(&bar[XB_XGEN(b.x)], 1u);
            asm volatile("s_waitcnt vmcnt(0)" ::: "memory");
        } else {
            XB_SPIN(xb_ld(&bar[XB_XGEN(b.x)]) == gen, bar);
            __builtin_amdgcn_fence(__ATOMIC_ACQUIRE, "agent");
            asm volatile("s_waitcnt vmcnt(0)" ::: "memory");
        }
    }
    __syncthreads();
}
__device__ __forceinline__ void xcd_barrier_local(const XcdBarrier& b) {
    asm volatile("s_waitcnt vmcnt(0)" ::: "memory");
    __syncthreads();
    if (threadIdx.x == 0) {
        unsigned* bar = b.bar;
        __builtin_amdgcn_s_waitcnt(0);
        const unsigned nloc = b.st[0];
        const unsigned old = xb_add(&bar[XB_XSUB(b.x)], 1u);
        const unsigned gen = old / nloc;
        if (old + 1u == (gen + 1u) * nloc) xb_add(&bar[XB_XGEN(b.x)], 1u);
        else XB_SPIN(xb_ld(&bar[XB_XGEN(b.x)]) == gen, bar);
        __builtin_amdgcn_fence(__ATOMIC_ACQUIRE, "agent");
        asm volatile("s_waitcnt vmcnt(0)" ::: "memory");
    }
    __syncthreads();
}
using pg8::bf_lo; using pg8::bf_hi; using pg8::sigm; using pg8::gelu_t;
struct Args { const float* in[28]; float* out; unsigned char* ws; int ph_lo, ph_hi; };
typedef const __attribute__((address_space(4))) Args* KArgsP;
__device__ __forceinline__ KArgsP fresh_args() { KArgsP p = (KArgsP)__builtin_amdgcn_kernarg_segment_ptr(); asm volatile("" : "+s"(p)); return p; }

__device__ __forceinline__ float wave_sum(float v) {
#pragma unroll
    for (int o = 1; o < 64; o <<= 1) v += __shfl_xor(v, o);
    return v;
}
__device__ __forceinline__ void transpose_item(const float* W, int K, int N, const float* gk, bf16* WT, LAS float* scr, int item, int lane, int rmap = 0) {
    const int nblk = N / 32, kb = item / nblk, nb = item % nblk, k0 = 64 * kb, n0 = 32 * nb;
    { const int kr = lane >> 3, nq = lane & 7; f32x4 v[8];
#pragma unroll
      for (int i = 0; i < 8; ++i) v[i] = *(const GAS f32x4*)(W + (size_t)(k0 + kr + 8 * i) * N + n0 + 4 * nq);
#pragma unroll
      for (int i = 0; i < 8; ++i) { const int kk = kr + 8 * i; const float gs = gk ? gk[k0 + kk] : 1.0f; LAS float* d = scr + kk * 33 + 4 * nq; d[0] = v[i].x * gs; d[1] = v[i].y * gs; d[2] = v[i].z * gs; d[3] = v[i].w * gs; } }
    LDS_WAIT(); asm volatile("" ::: "memory");
    const int c = lane & 7;
#pragma unroll
    for (int j = 0; j < 4; ++j) { const int n = (lane >> 3) + 8 * j; const LAS float* s = scr + (8 * c) * 33 + n;
        v4u o; o.x = pk2(s[0 * 33], s[1 * 33]); o.y = pk2(s[2 * 33], s[3 * 33]); o.z = pk2(s[4 * 33], s[5 * 33]); o.w = pk2(s[6 * 33], s[7 * 33]);
        int nd = n0;
        if (rmap == 1) nd = (n0 < DFF) ? 256 * (n0 / 128) + (n0 % 128) : 256 * ((n0 - DFF) / 128) + 128 + ((n0 - DFF) % 128);
        if (rmap == 2 && n0 < 2048) nd = 256 * (n0 / 256) + 128 * ((n0 % 64) / 32) + 32 * ((n0 % 256) / 64);
        if (rmap == 2 && n0 >= 4096) { const int c = (n0 - 4096) % 2048; nd = 4096 + 256 * (c / 128) + (c % 128) + (n0 >= 6144 ? 128 : 0); }
        *(GAS v4u*)(WT + (size_t)(nd + n) * K + k0 + 8 * c) = o; }
    LDS_WAIT(); asm volatile("" ::: "memory");
}
constexpr int CONV_I_IN = (DM / 64) * (NIN / 32);
__device__ __forceinline__ void ph_convert(KArgsP ap, LAS unsigned char* lds, int l, int gw, int NGW, int wave, int lane, int it_lo = 0, int it_hi = 1 << 30) {
    LAS float* scr = (LAS float*)(lds + wave * 16384);
    unsigned char* ws = ap->ws;
    constexpr int I_IN = (DM / 64) * (NIN / 32), I_GLU = (DS / 64) * (DS / 32), I_BA = (DS / 64) * (DM / 32), I_OUT = (DM / 64) * (DM / 32), I_UP = (DM / 64) * (NUP / 32), I_DN = (DFF / 64) * (DM / 32);
    constexpr int NITEMS = I_IN + I_GLU + 2 * I_BA + I_OUT + I_UP + I_DN;
    static_assert(I_IN == CONV_I_IN, "");
    if (it_hi > NITEMS) it_hi = NITEMS;
    for (int it = it_lo + gw; it < it_hi; it += NGW) {
        int r = it;
        if (r < I_IN)  { transpose_item(ap->in[2] + (size_t)l * DM * NIN, DM, NIN, ap->in[1] + (size_t)l * DM, (bf16*)(ws + WS_WIN), scr, r, lane, 2); continue; } r -= I_IN;
        if (r < I_GLU) { transpose_item(ap->in[18] + (size_t)l * DS * DS, DS, DS, nullptr, (bf16*)(ws + WS_WGLU), scr, r, lane); continue; } r -= I_GLU;
        if (r < I_BA)  { transpose_item(ap->in[20] + (size_t)l * DS * DM, DS, DM, nullptr, (bf16*)(ws + WS_WBA), scr, r, lane); continue; } r -= I_BA;
        if (r < I_BA)  { transpose_item(ap->in[21] + (size_t)l * DS * DM, DS, DM, nullptr, (bf16*)(ws + WS_WBS), scr, r, lane); continue; } r -= I_BA;
        if (r < I_OUT) { transpose_item(ap->in[22] + (size_t)l * DM * DM, DM, DM, nullptr, (bf16*)(ws + WS_WOUT), scr, r, lane); continue; } r -= I_OUT;
        if (r < I_UP)  { transpose_item(ap->in[24] + (size_t)l * DM * NUP, DM, NUP, ap->in[23] + (size_t)l * DM, (bf16*)(ws + WS_WUP), scr, r, lane, 1); continue; } r -= I_UP;
        transpose_item(ap->in[27] + (size_t)l * DFF * DM, DFF, DM, nullptr, (bf16*)(ws + WS_WDN), scr, r, lane);
    }
}
__device__ __forceinline__ void ph_xprep(const float* src, bf16* xb, float* ssq, int gw, int NGW, int lane) {
    for (int m = gw; m < MR; m += NGW) {
        const GAS f32x4* xr = (const GAS f32x4*)(src + (size_t)m * DM) + lane;
        f32x4 v[8]; float s = 0.f;
#pragma unroll
        for (int j = 0; j < 8; ++j) { v[j] = xr[64 * j]; s += (v[j].x * v[j].x + v[j].y * v[j].y) + (v[j].z * v[j].z + v[j].w * v[j].w); }
        s = wave_sum(s);
        if (lane < 32) ssq[(size_t)m * 32 + lane] = (lane == 0) ? s : 0.f;
        GAS unsigned long long* o8 = (GAS unsigned long long*)(xb + (size_t)m * DM) + lane;
#pragma unroll
        for (int j = 0; j < 8; ++j) { const unsigned h0 = pk2(v[j].x, v[j].y), h1 = pk2(v[j].z, v[j].w); o8[64 * j] = (unsigned long long)h0 | ((unsigned long long)h1 << 32); }
    }
}
__device__ __forceinline__ void ph_conv_fix(KArgsP ap, int l, int vcu, int G, int tid) {
    const bf16* RAW = (const bf16*)(ap->ws + WS_RAW); bf16* Gb = (bf16*)(ap->ws + WS_G);
    const float* cw = ap->in[25] + (size_t)l * 3 * NUP; const float* cb = ap->in[26] + (size_t)l * NUP;
    constexpr int NF8 = DFF / 8; constexpr long total = (long)(MR / 256) * 4 * NF8;
    const bool grp = (G % 8 == 0); const int per = grp ? G / 8 : G; const long it0 = grp ? (long)(vcu / per) * (total / 8) : 0, it1 = grp ? it0 + total / 8 : total, NT = (long)per * NTHR;
    for (long it = it0 + (long)(grp ? vcu % per : vcu) * NTHR + tid; it < it1; it += NT) {
        const int f = (int)(it % NF8) * 8, q = (int)(it / NF8), r = q & 1, which = (q >> 1) & 1, pm = q >> 2;
        float av[8], vv[8];
        { const f32x4 b0 = *(const f32x4*)(cb + f), b1 = *(const f32x4*)(cb + f + 4), b2 = *(const f32x4*)(cb + DFF + f), b3 = *(const f32x4*)(cb + DFF + f + 4);
          av[0] = b0.x; av[1] = b0.y; av[2] = b0.z; av[3] = b0.w; av[4] = b1.x; av[5] = b1.y; av[6] = b1.z; av[7] = b1.w;
          vv[0] = b2.x; vv[1] = b2.y; vv[2] = b2.z; vv[3] = b2.w; vv[4] = b3.x; vv[5] = b3.y; vv[6] = b3.z; vv[7] = b3.w; }
#pragma unroll
        for (int jj = 0; jj < 3; ++jj) {
            const int sq = r + jj;
            const bf16* src;
            if (which == 1) src = RAW + ((size_t)pm * 8 + 2 + sq) * NUP;
            else if (sq >= 2) src = RAW + ((size_t)pm * 8 + (sq - 2)) * NUP;
            else { if ((pm & 7) == 0) continue; src = RAW + ((size_t)(pm - 1) * 8 + 6 + sq) * NUP; }
            const v4u wa = *(const GAS v4u*)(src + f), wv = *(const GAS v4u*)(src + DFF + f);
            const float* c0 = cw + (size_t)jj * NUP + f;
            const f32x4 ca0 = *(const f32x4*)c0, ca1 = *(const f32x4*)(c0 + 4), cv0 = *(const f32x4*)(c0 + DFF), cv1 = *(const f32x4*)(c0 + DFF + 4);
            av[0] += ca0.x * bf_lo(wa.x); av[1] += ca0.y * bf_hi(wa.x); av[2] += ca0.z * bf_lo(wa.y); av[3] += ca0.w * bf_hi(wa.y);
            av[4] += ca1.x * bf_lo(wa.z); av[5] += ca1.y * bf_hi(wa.z); av[6] += ca1.z * bf_lo(wa.w); av[7] += ca1.w * bf_hi(wa.w);
            vv[0] += cv0.x * bf_lo(wv.x); vv[1] += cv0.y * bf_hi(wv.x); vv[2] += cv0.z * bf_lo(wv.y); vv[3] += cv0.w * bf_hi(wv.y);
            vv[4] += cv1.x * bf_lo(wv.z); vv[5] += cv1.y * bf_hi(wv.z); vv[6] += cv1.z * bf_lo(wv.w); vv[7] += cv1.w * bf_hi(wv.w); }
        v4u o; o.x = pk2(gelu_t(av[0]) * vv[0], gelu_t(av[1]) * vv[1]); o.y = pk2(gelu_t(av[2]) * vv[2], gelu_t(av[3]) * vv[3]);
        o.z = pk2(gelu_t(av[4]) * vv[4], gelu_t(av[5]) * vv[5]); o.w = pk2(gelu_t(av[6]) * vv[6], gelu_t(av[7]) * vv[7]);
        *(GAS v4u*)(Gb + (size_t)(256 * pm + 128 * which + r) * DFF + f) = o;
    }
}
namespace att {
typedef short bf16x8 __attribute__((ext_vector_type(8)));
typedef short s16x4 __attribute__((ext_vector_type(4)));
typedef float f32x16 __attribute__((ext_vector_type(16)));
typedef unsigned u32x4 __attribute__((ext_vector_type(4)));
__device__ __forceinline__ int crow(int r, int hi) { return (r & 3) + 8 * (r >> 2) + 4 * hi; }
__device__ __forceinline__ s16x4 vtr(const LAS unsigned char* p) { return __builtin_bit_cast(s16x4, __builtin_amdgcn_ds_read_tr16_b64_v4i16((LAS s16x4*)p)); }
__device__ __forceinline__ void glds16(const void* gsrc, unsigned lds_dst) { unsigned keep;
    asm volatile("s_mov_b32 %0, m0\n\ts_mov_b32 m0, %2\n\ts_nop 0\n\tglobal_load_lds_dwordx4 %1, off\n\ts_mov_b32 m0, %0" : "=&s"(keep) : "v"(gsrc), "s"(lds_dst) : "memory"); }
__device__ __forceinline__ void glds16s(const void* base, unsigned voff, unsigned lds_dst) { unsigned keep;
    asm volatile("s_mov_b32 %0, m0\n\ts_mov_b32 m0, %3\n\ts_nop 0\n\tglobal_load_lds_dwordx4 %1, %2\n\ts_mov_b32 m0, %0" : "=&s"(keep) : "v"(voff), "s"(base), "s"(lds_dst) : "memory"); }
constexpr int WSF_OFF = LDSCTL_OFF + 1024;
}
__device__ __forceinline__ void ph_attn_mfma(KArgsP ap, LAS unsigned char* lds, int l, int vcu, int G, int wave, int lane) {
    using namespace att;
    const bf16* PROJ = (const bf16*)(ap->ws + WS_PROJ); bf16* ON = (bf16*)(ap->ws + WS_ON);
    const int r32 = lane & 31, hi = lane >> 5, c = wave >> 2, wq = wave & 3;
    float s1 = 0.f, s2 = 0.f;
    for (int d = 0; d < 64; ++d) { s1 += ap->in[5][l * 64 + d] * ap->in[6][l * 64 + d]; s2 += ap->in[7][l * 64 + d] * ap->in[8][l * 64 + d]; }
    const float lam_init = 0.8f - 0.6f * __builtin_amdgcn_exp2f(-0.3f * LOG2E * (float)l), lam = __builtin_amdgcn_exp2f(s1 * LOG2E) - __builtin_amdgcn_exp2f(s2 * LOG2E) + lam_init;
    const float* sg = ap->in[9] + l * 128;
    LAS float* XCH = (LAS float*)lds;
    LAS float* wsf = (LAS float*)(lds + WSF_OFF) + wave * 64;
    const unsigned lds0 = (unsigned)(uintptr_t)lds;
    const unsigned voffK = (unsigned)((lane * NIN + 2 * wave * 8) * 2);
    const unsigned voffV0 = (unsigned)(((16 * (2 * (wave & 1)) + (lane >> 2)) * NIN + (wave >> 1) * 32 + (lane & 3) * 8) * 2), voffV1 = voffV0 + (unsigned)(16 * NIN * 2);
    const int sper = (G % 8 == 0) ? G / 8 : G, sbase = (G % 8 == 0) ? (vcu / sper) * (NB * NH) : 0, slim = (G % 8 == 0) ? NB * NH : NB * NH * 8;
    for (int sl = (G % 8 == 0) ? vcu % sper : vcu; sl < slim; sl += sper) { const int su = sbase + sl;
        const int bh = su >> 3, pi = su & 7, b = bh >> 3, h = bh & 7;
        const float sl2 = __builtin_amdgcn_exp2f(-(float)(h + 1)) * LOG2E;
        const bf16* Kg = PROJ + (size_t)b * SEQ * NIN + OFF_K + h * 128;
        const bf16* Vg = PROJ + (size_t)b * SEQ * NIN + OFF_V + h * 128;
#pragma unroll 1
        for (int half = 0; half < 2; ++half) {
            const int qb = half ? 15 - pi : pi, NT = 2 * qb + 2, myNT = (wq < 2) ? NT - 1 : NT, q0 = 128 * qb;
            const bf16* Qw = PROJ + ((size_t)b * SEQ + q0 + 32 * wq + r32) * NIN + h * 128 + c * 64;
#define ATT_STAGE_K(tt) do { const bf16* kb2_ = Kg + (size_t)(64 * (tt)) * NIN; const unsigned ld_ = (unsigned)__builtin_amdgcn_readfirstlane((int)(lds0 + ((tt) & 3) * 32768 + 2 * wave * 1024)); \
                glds16s(kb2_, voffK, ld_); glds16s(kb2_, voffK + 16u, ld_ + 1024u); } while (0)
#define ATT_STAGE_V(tt) do { const bf16* vb2_ = Vg + (size_t)(64 * (tt)) * NIN; const unsigned ld_ = (unsigned)__builtin_amdgcn_readfirstlane((int)(lds0 + ((tt) & 3) * 32768 + 16384 + 2 * wave * 1024)); \
                glds16s(vb2_, voffV0, ld_); glds16s(vb2_, voffV1, ld_ + 1024u); } while (0)
#define ATT_QK(tt, P0, P1, C0, C1) do { const LAS unsigned char* kb_ = lds + ((tt) & 3) * 32768 + (8 * c + hi) * 1024 + r32 * 16; \
                bf16x8 kf_[8]; \
                _Pragma("unroll") for (int d0 = 0; d0 < 4; ++d0) { kf_[2 * d0] = *(const LAS bf16x8*)(kb_ + d0 * 2048); kf_[2 * d0 + 1] = *(const LAS bf16x8*)(kb_ + d0 * 2048 + 512); } \
                __builtin_amdgcn_sched_barrier(0); __builtin_amdgcn_s_setprio(1); \
                P0 = __builtin_amdgcn_mfma_f32_32x32x16_bf16(kf_[0], qr[0], C0, 0, 0, 0); P1 = __builtin_amdgcn_mfma_f32_32x32x16_bf16(kf_[1], qr[0], C1, 0, 0, 0); \
                _Pragma("unroll") for (int d0 = 1; d0 < 4; ++d0) { P0 = __builtin_amdgcn_mfma_f32_32x32x16_bf16(kf_[2 * d0], qr[d0], P0, 0, 0, 0); P1 = __builtin_amdgcn_mfma_f32_32x32x16_bf16(kf_[2 * d0 + 1], qr[d0], P1, 0, 0, 0); } \
                __builtin_amdgcn_s_setprio(0); __builtin_amdgcn_sched_barrier(0); } while (0)
            bf16x8 qr[4];
#pragma unroll
            for (int d0 = 0; d0 < 4; ++d0) qr[d0] = *(const bf16x8*)(Qw + d0 * 16 + hi * 8);
            asm volatile("" : "+v"(qr[0]), "+v"(qr[1]), "+v"(qr[2]), "+v"(qr[3]) :: "memory");
            ATT_STAGE_K(0); ATT_STAGE_V(0); ATT_STAGE_K(1); ATT_STAGE_V(1);
            if (NT > 2) { ATT_STAGE_K(2); ATT_STAGE_V(2); }
            f32x16 o[4];
#pragma unroll
            for (int d0 = 0; d0 < 4; ++d0)
#pragma unroll
                for (int r = 0; r < 16; ++r) o[d0][r] = 0.f;
            float mrun = 0.f, l_reg = 0.f;
            const float qd = (float)(q0 + 32 * wq + r32 - 4 * hi);
            f32x16 B0, B1;
#pragma unroll
            for (int r = 0; r < 16; ++r) { const float kr = (float)((r & 3) + 8 * (r >> 2)); B0[r] = -sl2 * (qd - kr); B1[r] = -sl2 * (qd - 32.0f - kr); }
            const float bstep = 64.0f * sl2;
#pragma unroll 1
            for (int t = 0; t < NT; ++t) {
                if (t + 2 < NT) asm volatile("s_waitcnt vmcnt(8) lgkmcnt(0)\n\ts_barrier" ::: "memory"); else asm volatile("s_waitcnt vmcnt(0) lgkmcnt(0)\n\ts_barrier" ::: "memory");
                if (t + 3 < NT) { ATT_STAGE_K(t + 3); ATT_STAGE_V(t + 3); }
                if (t < myNT) {
                    const LAS unsigned char* Vb = lds + (t & 3) * 32768 + 16384;
                    if (t == myNT - 1) {
                        const float dq = qd - (float)(64 * t);
#pragma unroll
                        for (int r = 0; r < 16; ++r) { const float kr = (float)((r & 3) + 8 * (r >> 2)); B0[r] = -sl2 * __builtin_fabsf(dq - kr) - mrun; B1[r] = -sl2 * __builtin_fabsf(dq - 32.0f - kr) - mrun; }
                    }
                    f32x16 p0, p1;
                    ATT_QK(t, p0, p1, B0, B1);
                    float rm = fmaxf(p0[0], p1[0]);
#pragma unroll
                    for (int r = 1; r < 16; ++r) rm = fmaxf(fmaxf(rm, p0[r]), p1[r]);
                    { auto rr = __builtin_amdgcn_permlane32_swap(__float_as_uint(rm), __float_as_uint(rm), false, false); rm = fmaxf(__uint_as_float(rr[0]), __uint_as_float(rr[1])); }
                    if (__builtin_amdgcn_ballot_w64(rm > 8.0f) != 0ull) {
                        const float dl = fmaxf(rm, 0.f), f = __builtin_amdgcn_exp2f(-dl); mrun += dl; l_reg *= f;
                        p0 = p0 - dl; p1 = p1 - dl; B0 = B0 - dl; B1 = B1 - dl;
                        if (hi == 0) wsf[r32] = f;
#pragma unroll
                        for (int r = 0; r < 16; ++r) { const float fr_ = wsf[crow(r, hi)];
#pragma unroll
                            for (int d0 = 0; d0 < 4; ++d0) o[d0][r] *= fr_; }
                    }
#pragma unroll
                    for (int r = 0; r < 16; ++r) { p0[r] = __builtin_amdgcn_exp2f(p0[r]); p1[r] = __builtin_amdgcn_exp2f(p1[r]); }
                    { const f32x16 sv = p0 + p1; float sacc = ((sv[0] + sv[1]) + (sv[2] + sv[3])) + ((sv[4] + sv[5]) + (sv[6] + sv[7])) + ((sv[8] + sv[9]) + (sv[10] + sv[11])) + ((sv[12] + sv[13]) + (sv[14] + sv[15])); l_reg += sacc; }
                    u32x4 pw[4];
#pragma unroll
                    for (int j = 0; j < 4; ++j) { pw[0][j] = pg8::cvt_pk_bf16(p0[2 * j], p0[2 * j + 1]); pw[1][j] = pg8::cvt_pk_bf16(p0[8 + 2 * j], p0[8 + 2 * j + 1]);
                        pw[2][j] = pg8::cvt_pk_bf16(p1[2 * j], p1[2 * j + 1]); pw[3][j] = pg8::cvt_pk_bf16(p1[8 + 2 * j], p1[8 + 2 * j + 1]); }
                    const LAS unsigned char* vp0 = Vb + ((lane >> 4) & 1) * 32 + (lane & 3) * 8 + (4 * hi + ((lane & 15) >> 2)) * 64;
                    { s16x4 vl[2][4], vh[2][4];
#pragma unroll
                      for (int ks = 0; ks < 4; ++ks) { vl[0][ks] = vtr(vp0 + ks * 1024); vh[0][ks] = vtr(vp0 + ks * 1024 + 512); }
                      __builtin_amdgcn_sched_barrier(0);
#pragma unroll
                      for (int d0 = 0; d0 < 4; ++d0) {
                          if (d0 < 3) {
#pragma unroll
                              for (int ks = 0; ks < 4; ++ks) { vl[(d0 + 1) & 1][ks] = vtr(vp0 + (d0 + 1) * 4096 + ks * 1024); vh[(d0 + 1) & 1][ks] = vtr(vp0 + (d0 + 1) * 4096 + ks * 1024 + 512); } }
                          __builtin_amdgcn_sched_barrier(0);
#pragma unroll
                          for (int ks = 0; ks < 4; ++ks) { const s16x4 a = vl[d0 & 1][ks], bq = vh[d0 & 1][ks]; const bf16x8 vf = (bf16x8){a[0], a[1], a[2], a[3], bq[0], bq[1], bq[2], bq[3]};
                              o[d0] = __builtin_amdgcn_mfma_f32_32x32x16_bf16(__builtin_bit_cast(bf16x8, pw[ks]), vf, o[d0], 0, 0, 0); }
                          __builtin_amdgcn_sched_barrier(0);
                      } }
                    B0 = B0 + bstep; B1 = B1 + bstep;
                }
            }
#undef ATT_STAGE_K
#undef ATT_STAGE_V
#undef ATT_QK
            { auto rr = __builtin_amdgcn_permlane32_swap(__float_as_uint(l_reg), __float_as_uint(l_reg), false, false); l_reg = __uint_as_float(rr[0]) + __uint_as_float(rr[1]); }
            if (hi == 0) wsf[r32] = __builtin_amdgcn_rcpf(l_reg);
            float il[16];
#pragma unroll
            for (int r = 0; r < 16; ++r) il[r] = wsf[crow(r, hi)];
            __syncthreads();
            if (c == 1) {
#pragma unroll
                for (int d0 = 0; d0 < 4; ++d0)
#pragma unroll
                    for (int r = 0; r < 16; ++r) XCH[(32 * wq + crow(r, hi)) * 128 + 32 * d0 + r32] = o[d0][r] * il[r]; }
            __syncthreads();
            if (c == 0) {
#pragma unroll
                for (int d0 = 0; d0 < 4; ++d0)
#pragma unroll
                    for (int r = 0; r < 16; ++r) { const int ix = (32 * wq + crow(r, hi)) * 128 + 32 * d0 + r32; XCH[ix] = o[d0][r] * il[r] - lam * XCH[ix]; } }
            __syncthreads();
            { const int row = 16 * wave + (lane >> 2), qq = lane & 3;
              const LAS f32x4* xp = (const LAS f32x4*)(XCH + row * 128 + 32 * qq);
              f32x4 x[8]; float ss = 0.f;
#pragma unroll
              for (int i = 0; i < 8; ++i) { x[i] = xp[i]; ss += (x[i].x * x[i].x + x[i].y * x[i].y) + (x[i].z * x[i].z + x[i].w * x[i].w); }
              ss += __shfl_xor(ss, 1); ss += __shfl_xor(ss, 2);
              const float sc = __builtin_amdgcn_rsqf(ss * (1.0f / 128.0f) + EPS) * (1.0f - lam_init);
              GAS v4u* op = (GAS v4u*)(ON + ((size_t)b * SEQ + q0 + row) * DS + h * 128 + 32 * qq);
#pragma unroll
              for (int i = 0; i < 4; ++i) { const f32x4 g0 = *(const f32x4*)(sg + 32 * qq + 8 * i), g1 = *(const f32x4*)(sg + 32 * qq + 8 * i + 4); const f32x4 xa = x[2 * i], xb = x[2 * i + 1]; v4u w;
                  w.x = pk2(xa.x * sc * g0.x, xa.y * sc * g0.y); w.y = pk2(xa.z * sc * g0.z, xa.w * sc * g0.w); w.z = pk2(xb.x * sc * g1.x, xb.y * sc * g1.y); w.w = pk2(xb.z * sc * g1.z, xb.w * sc * g1.w); op[i] = w; } }
            __syncthreads();
        }
    }
    __syncthreads();
}
struct SsmPar { float dt, ar, ai, ph1; };
__device__ __forceinline__ SsmPar ssm_par(KArgsP ap, int l, int g, int p) {
    SsmPar q; q.dt = __builtin_amdgcn_exp2f(ap->in[12][(size_t)l * NG + g] * LOG2E); q.ar = ap->in[10][((size_t)l * NG + g) * NPS + p]; q.ai = ap->in[11][((size_t)l * NG + g) * NPS + p];
    q.ph1 = q.dt * q.ai * 0.15915494309189535f; return q;
}
__device__ __forceinline__ void ssm_apow(const SsmPar& q, float n, float& re, float& im) {
    const float mag = __builtin_amdgcn_exp2f(n * q.dt * q.ar * LOG2E), ph = __builtin_amdgcn_fractf(n * q.ph1);
    re = mag * __builtin_amdgcn_cosf(ph); im = mag * __builtin_amdgcn_sinf(ph);
}
__device__ __forceinline__ void ssm_f(const SsmPar& q, float& fre, float& fim) {
    float a1r, a1i; ssm_apow(q, 1.0f, a1r, a1i);
    const float iden = __builtin_amdgcn_rcpf(q.ar * q.ar + q.ai * q.ai), zr = a1r - 1.0f, zi = a1i; fre = (zr * q.ar + zi * q.ai) * iden; fim = (zi * q.ar - zr * q.ai) * iden;
}
__device__ __forceinline__ void ph_ssm_prep1(KArgsP ap, LAS unsigned char* lds, int l, int gw, int NGW, int wave, int lane) {
    float* Ktab = (float*)(ap->ws + WS_KTAB);
    const float* bre = ap->in[13] + (size_t)l * NG * NPS * NIS; const float* bim = ap->in[14] + (size_t)l * NG * NPS * NIS;
    const float* cre = ap->in[15] + (size_t)l * NG * NIS * NPS; const float* cim = ap->in[16] + (size_t)l * NG * NIS * NPS;
    LAS float* scr = (LAS float*)(lds + wave * 16384);
    for (int it = gw; it < NG * 16; it += NGW) {
        const int g = it >> 4, tau = it & 15;
#pragma unroll
        for (int j = 0; j < 4; ++j) { const int e4 = 4 * (lane + 64 * j);
            *(LAS f32x4*)(scr + e4) = *(const GAS f32x4*)(cre + g * 1024 + e4); *(LAS f32x4*)(scr + 1024 + e4) = *(const GAS f32x4*)(cim + g * 1024 + e4);
            *(LAS f32x4*)(scr + 2048 + e4) = *(const GAS f32x4*)(bre + g * 1024 + e4); *(LAS f32x4*)(scr + 3072 + e4) = *(const GAS f32x4*)(bim + g * 1024 + e4); }
        const SsmPar q = ssm_par(ap, l, g, lane);
        float fr_, fi_, tr_, ti_; ssm_f(q, fr_, fi_); ssm_apow(q, (float)tau, tr_, ti_);
        const float Er = tr_ * fr_ - ti_ * fi_, Ei = tr_ * fi_ + ti_ * fr_;
        LDS_WAIT(); asm volatile("" ::: "memory");
        float acc[4] = {0.f, 0.f, 0.f, 0.f}; const int o0 = lane >> 4, i = lane & 15;
#pragma unroll 1
        for (int p4 = 0; p4 < NPS; p4 += 4) {
            f32x4 crv[4], civ[4];
#pragma unroll
            for (int k = 0; k < 4; ++k) { crv[k] = *(const LAS f32x4*)(scr + (o0 + 4 * k) * 64 + p4); civ[k] = *(const LAS f32x4*)(scr + 1024 + (o0 + 4 * k) * 64 + p4); }
#pragma unroll
            for (int pp = 0; pp < 4; ++pp) { const int p = p4 + pp;
                const float er = __builtin_bit_cast(float, __builtin_amdgcn_readlane(__builtin_bit_cast(int, Er), p)), ei = __builtin_bit_cast(float, __builtin_amdgcn_readlane(__builtin_bit_cast(int, Ei), p));
                const float br = scr[2048 + p * 16 + i], bi = scr[3072 + p * 16 + i];
#pragma unroll
                for (int k = 0; k < 4; ++k) { const float cr = crv[k][pp], ci = civ[k][pp], zr = cr * er - ci * ei, zi = cr * ei + ci * er; acc[k] += zr * br - zi * bi; } }
        }
#pragma unroll
        for (int k = 0; k < 4; ++k) Ktab[(size_t)(g * 16 + tau) * 256 + lane + 64 * k] = acc[k];
        LDS_WAIT(); asm volatile("" ::: "memory");
    }
}
__device__ __forceinline__ void ph_ssm_prep2(KArgsP ap, int l, long gtid, long NT) {
    const float* Ktab = (const float*)(ap->ws + WS_KTAB); bf16* BtY = (bf16*)(ap->ws + WS_BTY); bf16* BtS = (bf16*)(ap->ws + WS_BTS);
    const float* bre = ap->in[13] + (size_t)l * NG * NPS * NIS; const float* bim = ap->in[14] + (size_t)l * NG * NPS * NIS;
    const float* cre = ap->in[15] + (size_t)l * NG * NIS * NPS; const float* cim = ap->in[16] + (size_t)l * NG * NIS * NPS; const float* dsk = ap->in[17] + (size_t)l * DS;
    constexpr long NY = (long)NG * 256 * 48, NS = (long)NG * 256 * 32;
    for (long it = gtid; it < NY + NS; it += NT) {
        float v[8];
        if (it < NY) {
            const int g = (int)(it / (256 * 48)), rem = (int)(it % (256 * 48)), n = rem / 48, k0 = (rem % 48) * 8, j = n >> 4, o = n & 15;
            if (k0 < 256) { const int s = k0 >> 4, i0 = k0 & 15;
#pragma unroll
                for (int e = 0; e < 8; ++e) { float x = 0.f; if (s <= j) x = Ktab[(size_t)(g * 16 + (j - s)) * 256 + o * 16 + i0 + e]; if (s == j && i0 + e == o) x += dsk[g * NIS + o]; v[e] = x; }
            } else { const int kk = k0 - 256;
#pragma unroll
                for (int e = 0; e < 8; ++e) { const int p = (kk + e) >> 1; const bool im = (e & 1) != 0; const SsmPar q = ssm_par(ap, l, g, p); float pr, pi_; ssm_apow(q, (float)(j + 1), pr, pi_);
                    const float cr = cre[(size_t)(g * NIS + o) * NPS + p], ci = cim[(size_t)(g * NIS + o) * NPS + p]; v[e] = im ? -(cr * pi_ + ci * pr) : (cr * pr - ci * pi_); } }
            v4u w; w.x = pk2(v[0], v[1]); w.y = pk2(v[2], v[3]); w.z = pk2(v[4], v[5]); w.w = pk2(v[6], v[7]);
            *(GAS v4u*)(BtY + ((size_t)g * 256 + n) * 384 + k0) = w;
        } else {
            const long r2 = it - NY; const int g = (int)(r2 / (256 * 32)), rem = (int)(r2 % (256 * 32)), n = rem / 32, k0 = (rem % 32) * 8;
            if (n < 128) { const int p = n >> 1, s = k0 >> 4, i0 = k0 & 15; const bool im = (n & 1) != 0;
                const SsmPar q = ssm_par(ap, l, g, p); float fr_, fi_, tr_, ti_; ssm_f(q, fr_, fi_); ssm_apow(q, (float)(15 - s), tr_, ti_);
                const float Er = tr_ * fr_ - ti_ * fi_, Ei = tr_ * fi_ + ti_ * fr_;
#pragma unroll
                for (int e = 0; e < 8; ++e) { const float br = bre[(size_t)(g * NPS + p) * NIS + i0 + e], bi = bim[(size_t)(g * NPS + p) * NIS + i0 + e]; v[e] = im ? (Er * bi + Ei * br) : (Er * br - Ei * bi); }
            } else {
#pragma unroll
                for (int e = 0; e < 8; ++e) v[e] = 0.f; }
            v4u w; w.x = pk2(v[0], v[1]); w.y = pk2(v[2], v[3]); w.z = pk2(v[4], v[5]); w.w = pk2(v[6], v[7]);
            *(GAS v4u*)(BtS + ((size_t)g * 256 + n) * 256 + k0) = w;
        }
    }
}
__device__ __forceinline__ void ssm_scan_unit(KArgsP ap, LAS unsigned char* lds, int l, int g, int b, int par, int wave, int lane) {
    const SsmPar q = ssm_par(ap, l, g, lane); float cr, ci, dr, di; ssm_apow(q, 16.0f, cr, ci); ssm_apow(q, 256.0f, dr, di);
    const unsigned* Sp = (const unsigned*)(ap->ws + WS_S) + ((size_t)g * 2048 + b * 128 + 16 * wave) * 64 + lane;
    unsigned* Up = (unsigned*)((bf16*)(ap->ws + WS_UCAT) + ((size_t)g * 2048 + b * 128 + 16 * wave) * 384 + 256) + lane;
    unsigned sv[16];
#pragma unroll
    for (int j = 0; j < 16; ++j) sv[j] = Sp[(size_t)j * 64];
    float tr = 0.f, ti = 0.f;
#pragma unroll
    for (int j = 0; j < 16; ++j) { const float nr = cr * tr - ci * ti + pg8::bf_lo(sv[j]), ni = cr * ti + ci * tr + pg8::bf_hi(sv[j]); tr = nr; ti = ni; }
    LAS float* T = (LAS float*)(lds + par * 4096);
    T[wave * 128 + lane] = tr; T[wave * 128 + 64 + lane] = ti;
    __syncthreads();
    float hr = 0.f, hi = 0.f;
    for (int v = 0; v < wave; ++v) { const float xr = T[v * 128 + lane], xi = T[v * 128 + 64 + lane]; const float nr = dr * hr - di * hi + xr, ni = dr * hi + di * hr + xi; hr = nr; hi = ni; }
#pragma unroll
    for (int j = 0; j < 16; ++j) {
        Up[(size_t)j * 192] = pg8::cvt_pk_bf16(hr, hi);
        const float nr = cr * hr - ci * hi + pg8::bf_lo(sv[j]), ni = cr * hi + ci * hr + pg8::bf_hi(sv[j]); hr = nr; hi = ni;
    }
}
__device__ __forceinline__ void ph_ssm_scan(KArgsP ap, LAS unsigned char* lds, int l, int vcu, int G, int wave, int lane) {
    int par = 0;
    for (int u = vcu; u < NB * NG; u += G) { ssm_scan_unit(ap, lds, l, u % NG, u / NG, par, wave, lane); par ^= 1; }
}
constexpr int RTAB_OFF = LDSCTL_OFF + 4096;
template <class Sched> __device__ __forceinline__ pg8::RstdTab build_rstd_tab(LAS unsigned char* lds, const Sched& S, const float* ssq, int tid) {
    pg8::RstdTab R; R.tab = (const LAS float*)(lds + RTAB_OFF); R.ssq = ssq; R.p0 = R.p1 = R.p2 = R.p3 = -1;
    int np = 0; pg8::Unit u;
    for (int i = 0; S.next(i, u); ++i) if (u.pm != R.p0 && u.pm != R.p1 && u.pm != R.p2 && u.pm != R.p3) { if (np == 0) R.p0 = u.pm; else if (np == 1) R.p1 = u.pm; else if (np == 2) R.p2 = u.pm; else if (np == 3) R.p3 = u.pm; ++np; }
    LAS float* tab = (LAS float*)(lds + RTAB_OFF);
#pragma unroll
    for (int pass = 0; pass < 2; ++pass) { const int k = 2 * pass + (tid >> 8); const int pm = (k == 0) ? R.p0 : (k == 1) ? R.p1 : (k == 2) ? R.p2 : R.p3;
        if (pm >= 0) { const GAS f32x4* sp = (const GAS f32x4*)(ssq + ((size_t)pm * 256 + (tid & 255)) * 32); float sm = 0.f;
#pragma unroll
            for (int j = 0; j < 8; ++j) { const f32x4 v = sp[j]; sm += (v.x + v.y) + (v.z + v.w); }
            tab[k * 256 + (tid & 255)] = __builtin_amdgcn_rsqf(sm * (1.0f / DM) + EPS); } }
    __syncthreads();
    return R;
}
#ifndef MK_PER_PHASE
#define MK_PER_PHASE 0
#endif
#define PH_LOCALS \
    KArgsP ap = fresh_args(); \
    int tid = threadIdx.x; asm volatile("" : "+v"(tid)); \
    const int lane = tid & 63, wave = __builtin_amdgcn_readfirstlane(tid >> 6); \
    int G = gridDim.x, bx = __builtin_amdgcn_readfirstlane(((volatile LAS int*)(lds + MISC_OFF))[12]); asm volatile("" : "+s"(G), "+s"(bx)); \
    const int vcu = (G % 8 == 0) ? (bx % 8) * (G / 8) + bx / 8 : bx, gw = vcu * NWAVES + wave, NGW = G * NWAVES; \
    unsigned char* const ws = ap->ws; (void)lane; (void)gw; (void)NGW; (void)ws; (void)vcu
__global__ void __launch_bounds__(NTHR, 2) fwd_kernel(Args a) {
    extern __shared__ __attribute__((aligned(16))) unsigned char lds_raw[];
    LAS unsigned char* lds = (LAS unsigned char*)lds_raw;
    for (int u = threadIdx.x; u < (LDS_BYTES - LDSCTL_OFF) / 4; u += NTHR) ((LAS unsigned*)(lds + LDSCTL_OFF))[u] = 0u;
    __syncthreads();
    (void)xcd_barrier_post((unsigned*)(fresh_args()->ws + WS_CTL) + CW_BAR, (volatile LAS unsigned*)(lds + MISC_OFF) + 8);
    if (threadIdx.x == 0) ((volatile LAS int*)(lds + MISC_OFF))[12] = (int)blockIdx.x;
    __syncthreads();
    const int lo = a.ph_lo, hi = a.ph_hi;
#define IN(k) (lo <= (k) && (k) < hi)
#define SEAM(k) do { if (IN(k) && IN((k) + 1)) { XcdBarrier b_; b_.bar = (unsigned*)(fresh_args()->ws + WS_CTL) + CW_BAR; b_.x = xb_xcc_id(); b_.st = (volatile LAS unsigned*)(lds + MISC_OFF) + 8; xcd_barrier(b_); } } while (0)
#define GEMM_PHASE(EpiT, Eobj, Aptr, Bptr, Nv, Kv) do { pg8::Gemm g_{(const pg8::bf16_t*)(Aptr), (const pg8::bf16_t*)(Bptr), MR, (Nv), (Kv), (Kv), (Kv), nullptr, nullptr}; pg8::StaticOrder S_; S_.init(MR, (Nv), G, bx); \
        pg8::gemm_phase<EpiT, pg8::StaticOrder, true, true>(lds, g_, S_, Eobj); } while (0)
#define SEAM_L(k) do { if (IN(k) && IN((k) + 1)) { XcdBarrier b_; b_.bar = (unsigned*)(fresh_args()->ws + WS_CTL) + CW_BAR; b_.x = xb_xcc_id(); b_.st = (volatile LAS unsigned*)(lds + MISC_OFF) + 8; \
        if (b_.st[2]) xcd_barrier_local(b_); else xcd_barrier(b_); } } while (0)
#define WSP(T, off) ((T*)(ws + (off)))

    if (IN(0)) { PH_LOCALS; ph_convert(ap, lds, 0, gw, NGW, wave, lane); ph_ssm_prep1(ap, lds, 0, gw, NGW, wave, lane); ph_xprep(ap->in[0], WSP(bf16, WS_XB), WSP(float, WS_RSTD), gw, NGW, lane); }
    SEAM(0);
    { volatile LAS unsigned* st_ = (volatile LAS unsigned*)(lds + MISC_OFF) + 8; if (threadIdx.x == 0 && st_[2]) ((volatile LAS int*)(lds + MISC_OFF))[12] = (int)(st_[3] * 8u + xb_xcc_id()); __syncthreads(); }
    for (int l = 0; l < NL; ++l) {
        const int p0 = 1 + PH_PER_LAYER * l;
        if (IN(p0 + 0)) { PH_LOCALS; { pg8::StaticOrder S0_; S0_.init(MR, NIN, G, bx); const pg8::RstdTab rt_ = build_rstd_tab(lds, S0_, WSP(float, WS_RSTD), tid);
              pg8::EpiWin E{WSP(pg8::bf16_t, WS_PROJ), WSP(pg8::bf16_t, WS_UCAT), rt_, ap->in[3] + l * 64, ap->in[4] + l * 64, QSCALE}; GEMM_PHASE(pg8::EpiWin, E, ws + WS_XB, ws + WS_WIN, NIN, DM); }

                                    ph_ssm_prep2(ap, l, (long)vcu * NTHR + tid, (long)G * NTHR); }
        SEAM(p0 + 0);
        if (IN(p0 + 1)) { PH_LOCALS;
            ph_attn_mfma(ap, lds, l, vcu, G, wave, lane);
            VM_WAIT(); __syncthreads();
            { pg8::Gemm g_{(const pg8::bf16_t*)(ws + WS_UCAT), (const pg8::bf16_t*)(ws + WS_BTS), NG * 2048, 256, 256, 384, 256, nullptr, nullptr}; pg8::GroupOrder S_{NG * 8, G, bx, 8}; pg8::EpiSsmS E{WSP(pg8::bf16_t, WS_S)};
              pg8::gemm_phase<pg8::EpiSsmS, pg8::GroupOrder, true, true>(lds, g_, S_, E); }
            VM_WAIT(); __syncthreads();
            { int par = 0; for (int L = bx; L < NG * 8; L += G) { ssm_scan_unit(ap, lds, l, L >> 3, 2 * (L & 7), par, wave, lane); ssm_scan_unit(ap, lds, l, L >> 3, 2 * (L & 7) + 1, par ^ 1, wave, lane); } }
            VM_WAIT(); __syncthreads();
            { pg8::Gemm g_{(const pg8::bf16_t*)(ws + WS_UCAT), (const pg8::bf16_t*)(ws + WS_BTY), NG * 2048, 256, 384, 384, 384, nullptr, nullptr}; pg8::GroupOrder S_{NG * 8, G, bx, 8}; pg8::EpiSsmY E{WSP(bf16, WS_YG)};
              pg8::gemm_phase<pg8::EpiSsmY, pg8::GroupOrder, true, true>(lds, g_, S_, E); }
        }
        SEAM_L(p0 + 1);
        if (IN(p0 + 2)) { PH_LOCALS; pg8::EpiGlu E{WSP(bf16, WS_Y2), WSP(bf16, WS_YG), DS, ap->in[19] + (size_t)l * DS}; GEMM_PHASE(pg8::EpiGlu, E, ws + WS_YG, ws + WS_WGLU, DS, DS); }
        SEAM_L(p0 + 2);
        if (IN(p0 + 3)) { PH_LOCALS; pg8::Gemm g_{(const pg8::bf16_t*)(ws + WS_ON), (const pg8::bf16_t*)(ws + WS_WBA), MR, DM, DS, DS, DS, (const pg8::bf16_t*)(ws + WS_Y2), (const pg8::bf16_t*)(ws + WS_WBS)};
            pg8::TwoSegOrder S_; S_.base.init(MR, DM, G, bx); pg8::EpiGateF E{WSP(pg8::bf16_t, WS_MIX), DM, (const unsigned char*)(WSP(pg8::bf16_t, WS_PROJ) + OFF_GA), NIN * 2};
            pg8::gemm_phase<pg8::EpiGateF, pg8::TwoSegOrder, true, true>(lds, g_, S_, E); }
        SEAM_L(p0 + 3);
        if (IN(p0 + 4)) { PH_LOCALS; pg8::EpiResid E{WSP(pg8::bf16_t, WS_XB), WSP(float, WS_RSTD), nullptr}; GEMM_PHASE(pg8::EpiResid, E, ws + WS_MIX, ws + WS_WOUT, DM, DM);
        }
        SEAM(p0 + 4);
        if (IN(p0 + 5)) { PH_LOCALS; pg8::StaticOrder S0_; S0_.init(MR, NUP, G, bx); const pg8::RstdTab rt_ = build_rstd_tab(lds, S0_, WSP(float, WS_RSTD), tid);
            pg8::EpiUpConv E{WSP(pg8::bf16_t, WS_G), WSP(pg8::bf16_t, WS_RAW), rt_, ap->in[25] + (size_t)l * 3 * NUP, ap->in[26] + (size_t)l * NUP}; GEMM_PHASE(pg8::EpiUpConv, E, ws + WS_XB, ws + WS_WUP, NUP, DM);
            { const int nwg_ = (MR / 256) * (NUP / 256), rem_ = nwg_ % G; if (rem_ != 0 && bx >= rem_ && l + 1 < NL) ph_convert(ap, lds, l + 1, (bx - rem_) * NWAVES + wave, (G - rem_) * NWAVES, wave, lane, 0, CONV_I_IN); } }
        SEAM_L(p0 + 5);
        if (IN(p0 + 6)) { PH_LOCALS; ph_conv_fix(ap, l, vcu, G, tid); }
        SEAM_L(p0 + 6);
        if (IN(p0 + 7)) { PH_LOCALS; pg8::EpiResid E{WSP(pg8::bf16_t, WS_XB), WSP(float, WS_RSTD), (l == NL - 1) ? ap->out : nullptr}; GEMM_PHASE(pg8::EpiResid, E, ws + WS_G, ws + WS_WDN, DM, DFF); }
        SEAM(p0 + 7);
        if (IN(p0 + 8) && l + 1 < NL) { PH_LOCALS; ph_convert(ap, lds, l + 1, gw, NGW, wave, lane, (((MR / 256) * (NUP / 256)) % G != 0) ? CONV_I_IN : 0); ph_ssm_prep1(ap, lds, l + 1, gw, NGW, wave, lane); }
        SEAM(p0 + 8);
    }
#undef IN
#undef SEAM
#undef GEMM_PHASE
}

extern "C" void kernel_launch(void* const* d_in, const int* in_sizes, int n_in, void* d_out, int out_size, void* d_ws, size_t ws_size, hipStream_t stream) {
    static int grid = 0;
    if (grid == 0) {
        if (n_in != 28 || in_sizes[0] != MR * DM || out_size != MR * DM || ws_size < WS_END) { fprintf(stderr, "kernel_launch: unexpected shapes / workspace (n_in %d, ws %zu, need %zu); nothing launched\n", n_in, ws_size, (size_t)WS_END); grid = -1; return; }
        int dev = 0, cus = 0, per_cu = 0;
        if (hipGetDevice(&dev) != hipSuccess || hipDeviceGetAttribute(&cus, hipDeviceAttributeMultiprocessorCount, dev) != hipSuccess) { grid = -1; return; }
        if (hipFuncSetAttribute((const void*)fwd_kernel, hipFuncAttributeMaxDynamicSharedMemorySize, LDS_BYTES) != hipSuccess) { fprintf(stderr, "kernel_launch: hipFuncSetAttribute failed\n"); grid = -1; return; }
        if (hipOccupancyMaxActiveBlocksPerMultiprocessor(&per_cu, (const void*)fwd_kernel, NTHR, LDS_BYTES) != hipSuccess || per_cu < 1) { fprintf(stderr, "kernel_launch: occupancy query says %d\n", per_cu); }
        (void)hipGetLastError();
        grid = cus;
    }
    if (grid < 0) return;
    if (hipMemsetAsync((char*)d_ws + WS_CTL, 0, CTL_ZERO_BYTES, stream) != hipSuccess) return;
    Args a{};
    for (int i = 0; i < 28; ++i) a.in[i] = (const float*)d_in[i];
    a.out = (float*)d_out; a.ws = (unsigned char*)d_ws;
#if MK_PER_PHASE
    for (int ph = 0; ph < N_PHASES - 1; ++ph) { a.ph_lo = ph; a.ph_hi = ph + 1; hipLaunchKernelGGL(fwd_kernel, dim3(grid), dim3(NTHR), LDS_BYTES, stream, a); }
#else
    a.ph_lo = 0; a.ph_hi = N_PHASES;
    hipLaunchKernelGGL(fwd_kernel, dim3(grid), dim3(NTHR), LDS_BYTES, stream, a);
#endif
    const hipError_t le = hipPeekAtLastError();
    if (le != hipSuccess) fprintf(stderr, "kernel_launch: launch failed: %s\n", hipGetErrorName(le));
}
```

```cpp
#include <hip/hip_runtime.h>
#include <cstdio>
#include <cstdint>
namespace pg8 {
#define PG8_LAS __attribute__((address_space(3)))
typedef unsigned short bf16_t;
typedef short bf16x8 __attribute__((ext_vector_type(8)));
typedef float f32x4 __attribute__((ext_vector_type(4)));
typedef unsigned u32x4 __attribute__((ext_vector_type(4)));
constexpr int BM = 256, BK = 64, HALF = 128, HTB = HALF * BK * 2  , STAGE_BYTES = 8 * HTB, NXCD = 8, WGM = 8;

__host__ __device__ __forceinline__ int lds_byte(int r, int c) { const int st = (r >> 4) * 2 + (c >> 5), rr = r & 15, cc = c & 31, ob = rr * 64 + cc * 2; return st * 1024 + (ob ^ (((ob >> 9) & 1) << 5)); }
__host__ __device__ __forceinline__ void stage_rc(int b, int& R, int& C) { const int st = b / 1024, sb = b % 1024, swz = sb ^ (((sb >> 9) & 1) << 5); R = (st >> 1) * 16 + swz / 64; C = (st & 1) * 32 + (swz % 64) / 2; }
__host__ __device__ __forceinline__ int perm32(int rho) { const int n = rho >> 4, i = rho & 15; return 8 * (i >> 2) + 4 * n + (i & 3); }

struct Unit { int pm, pn, seg; };
struct Gemm { const bf16_t* A; const bf16_t* Bt; int M, N, K, lda, ldb; const bf16_t* A2; const bf16_t* Bt2; };

struct StaticOrder {
    int nM, nN, nwg, G, c;
    __host__ __device__ void init(int M, int N, int G_, int c_) { nM = M / BM; nN = N / BM; nwg = nM * nN; G = G_; c = c_; }
    __host__ __device__ bool next(int i, Unit& u) const {
        const long L = (long)i * G + c; if (L >= nwg) return false;
        int wgid = (int)L; { const int q = nwg / NXCD, r = nwg % NXCD, xcd = wgid % NXCD, off = wgid / NXCD; wgid = (xcd < r ? xcd * (q + 1) : r * (q + 1) + (xcd - r) * q) + off; }
        const int nig = WGM * nN, gid = wgid / nig, fm = gid * WGM, gsz = (nM - fm) < WGM ? (nM - fm) : WGM;
        u.pm = fm + ((wgid % nig) % gsz); u.pn = (wgid % nig) / gsz; u.seg = 0; return true;
    }
    __device__ __forceinline__ void a_ready(const Unit&) const {}
    __device__ __forceinline__ void done(const Unit&) const {}
};

__device__ __forceinline__ unsigned cvt_pk_bf16(float lo, float hi) { unsigned r; asm volatile("v_cvt_pk_bf16_f32 %0, %1, %2" : "=v"(r) : "v"(lo), "v"(hi)); return r; }
typedef float f32x2 __attribute__((ext_vector_type(2)));
__device__ __forceinline__ f32x2 gelu_pk(f32x2 v) {
    const f32x2 av = __builtin_elementwise_abs(v), d = av * 0.2316418882f + 1.0f;
    f32x2 t; t.x = __builtin_amdgcn_rcpf(d.x); t.y = __builtin_amdgcn_rcpf(d.y);
    f32x2 q = t * 0.5307027145f + (-0.7265760135f); q = q * t + 0.7107068705f; q = q * t + (-0.142248368f); q = q * t + 0.127414796f; q = q * t;
    const f32x2 s = (v * v) * (-0.72134752044f);
    f32x2 e; e.x = __builtin_amdgcn_exp2f(s.x); e.y = __builtin_amdgcn_exp2f(s.y);
    const f32x2 m = v * (q * e), r = v - m;
    f32x2 o; o.x = v.x < 0.f ? m.x : r.x; o.y = v.y < 0.f ? m.y : r.y; return o;
}

__device__ __forceinline__ float bf_lo(unsigned w) { return __uint_as_float(w << 16); }
__device__ __forceinline__ float bf_hi(unsigned w) { return __uint_as_float(w & 0xffff0000u); }
__device__ __forceinline__ float sigm(float z) { return __builtin_amdgcn_rcpf(1.0f + __builtin_amdgcn_exp2f(-1.4426950408889634f * z)); }
__device__ __forceinline__ f32x4 gelu_mul4(f32x4 x, f32x4 v) {
    const f32x4 t = x * x, w = t * (-2.302208198f * 0.044715f) + (-2.302208198f), z = x * w;
    f32x4 e; e[0] = __builtin_amdgcn_exp2f(z[0]); e[1] = __builtin_amdgcn_exp2f(z[1]); e[2] = __builtin_amdgcn_exp2f(z[2]); e[3] = __builtin_amdgcn_exp2f(z[3]);
    const f32x4 d = e + 1.0f; f32x4 r; r[0] = __builtin_amdgcn_rcpf(d[0]); r[1] = __builtin_amdgcn_rcpf(d[1]); r[2] = __builtin_amdgcn_rcpf(d[2]); r[3] = __builtin_amdgcn_rcpf(d[3]);
    return (x * v) * r;
}
__device__ __forceinline__ float gelu_t(float x) { const float u = x * (1.0f + 0.044715f * x * x); return x * __builtin_amdgcn_rcpf(1.0f + __builtin_amdgcn_exp2f(-2.302208198f * u)); }

__device__ __forceinline__ float sum_fq4(float v) {
    { auto r = __builtin_amdgcn_permlane16_swap(__float_as_uint(v), __float_as_uint(v), false, false); v = __uint_as_float(r[0]) + __uint_as_float(r[1]); }
    { auto r = __builtin_amdgcn_permlane32_swap(__float_as_uint(v), __float_as_uint(v), false, false); v = __uint_as_float(r[0]) + __uint_as_float(r[1]); }
    return v;
}
__device__ __forceinline__ float row_rstd(const float* ssq, int row, int fq) {
    const f32x4 a = *(const f32x4*)(ssq + (size_t)row * 32 + 8 * fq), b = *(const f32x4*)(ssq + (size_t)row * 32 + 8 * fq + 4);
    float s = ((a[0] + a[1]) + (a[2] + a[3])) + ((b[0] + b[1]) + (b[2] + b[3]));
    s = sum_fq4(s);
    return __builtin_amdgcn_rsqf(s * (1.0f / 2048.0f) + 1e-6f);
}
struct RstdTab { const PG8_LAS float* tab; int p0, p1, p2, p3; const float* ssq;
    __device__ __forceinline__ const PG8_LAS float* base(int pm) const { return (pm == p0) ? tab : (pm == p1) ? tab + 256 : (pm == p2) ? tab + 512 : (pm == p3) ? tab + 768 : (const PG8_LAS float*)nullptr; }
    __device__ __forceinline__ float get(const PG8_LAS float* tb, int row, int fq) const { return tb ? tb[row & 255] : row_rstd(ssq, row, fq); }
};
struct EpiGlu { static constexpr bool PERM = true, AFTER_DRAIN = false, ROWMAP = false, TWOSEG = false;
    bf16_t* O; const bf16_t* Y; int ld; const float* bias;
    __device__ __forceinline__ void operator()(const f32x4 (&acc)[2][2][4][2], const Unit& u, int wr, int wc, int fr, int fq) const {
        const int row0 = u.pm * BM + wr * 64 + fr, col0 = u.pn * BM + wc * 32 + 8 * fq;
        f32x4 bv[2][2];
#pragma unroll
        for (int bj = 0; bj < 2; ++bj)
#pragma unroll
            for (int n = 0; n < 2; ++n) bv[bj][n] = *(const f32x4*)(bias + col0 + bj * HALF + 4 * n);
#pragma unroll
        for (int ai = 0; ai < 2; ++ai) {
            u32x4 yv[4][2];
#pragma unroll
            for (int m = 0; m < 4; ++m)
#pragma unroll
                for (int bj = 0; bj < 2; ++bj) yv[m][bj] = *(const u32x4*)(Y + (size_t)(row0 + ai * HALF + m * 16) * ld + col0 + bj * HALF);
            asm volatile("" ::: "memory");
#pragma unroll
            for (int m = 0; m < 4; ++m) { const size_t off = (size_t)(row0 + ai * HALF + m * 16) * ld + col0;
#pragma unroll
                for (int bj = 0; bj < 2; ++bj) { const f32x4 z0 = acc[ai][bj][m][0] + bv[bj][0], z1 = acc[ai][bj][m][1] + bv[bj][1];
                    const u32x4 y = yv[m][bj];
                    u32x4 w; w.x = cvt_pk_bf16(bf_lo(y.x) * sigm(z0[0]), bf_hi(y.x) * sigm(z0[1])); w.y = cvt_pk_bf16(bf_lo(y.y) * sigm(z0[2]), bf_hi(y.y) * sigm(z0[3]));
                    w.z = cvt_pk_bf16(bf_lo(y.z) * sigm(z1[0]), bf_hi(y.z) * sigm(z1[1])); w.w = cvt_pk_bf16(bf_lo(y.w) * sigm(z1[2]), bf_hi(y.w) * sigm(z1[3]));
                    *(u32x4*)(O + off + bj * HALF) = w; } }
            asm volatile("" ::: "memory");
        }
    }
};
struct EpiResid { static constexpr bool PERM = true, AFTER_DRAIN = false, ROWMAP = false, TWOSEG = false;
    bf16_t* XB; float* ssq; float* OUT;
    __device__ __forceinline__ void operator()(const f32x4 (&acc)[2][2][4][2], const Unit& u, int wr, int wc, int fr, int fq) const {
        const int row0 = u.pm * BM + wr * 64 + fr, col0 = u.pn * BM + wc * 32 + 8 * fq;
#pragma unroll
        for (int ai = 0; ai < 2; ++ai)
#pragma unroll
        for (int mh = 0; mh < 2; ++mh) {
            u32x4 hv[2][2];
#pragma unroll
            for (int m2 = 0; m2 < 2; ++m2)
#pragma unroll
                for (int bj = 0; bj < 2; ++bj) { const size_t off = (size_t)(row0 + ai * HALF + (2 * mh + m2) * 16) * 2048 + col0 + bj * HALF; hv[m2][bj] = *(const u32x4*)(XB + off); }
            asm volatile("" ::: "memory");
            float ssv[2];
#pragma unroll
            for (int m2 = 0; m2 < 2; ++m2) { const int m = 2 * mh + m2, row = row0 + ai * HALF + m * 16; float ss = 0.f;
#pragma unroll
                for (int bj = 0; bj < 2; ++bj) { const size_t off = (size_t)row * 2048 + col0 + bj * HALF; const u32x4 h = hv[m2][bj];
                    const f32x4 x0 = (f32x4){bf_lo(h.x), bf_hi(h.x), bf_lo(h.y), bf_hi(h.y)} + acc[ai][bj][m][0];
                    const f32x4 x1 = (f32x4){bf_lo(h.z), bf_hi(h.z), bf_lo(h.w), bf_hi(h.w)} + acc[ai][bj][m][1];
                    ss += ((x0[0] * x0[0] + x0[1] * x0[1]) + (x0[2] * x0[2] + x0[3] * x0[3])) + ((x1[0] * x1[0] + x1[1] * x1[1]) + (x1[2] * x1[2] + x1[3] * x1[3]));
                    if (OUT) { *(f32x4*)(OUT + off) = x0; *(f32x4*)(OUT + off + 4) = x1; }
                    else { u32x4 w; w.x = cvt_pk_bf16(x0[0], x0[1]); w.y = cvt_pk_bf16(x0[2], x0[3]); w.z = cvt_pk_bf16(x1[0], x1[1]); w.w = cvt_pk_bf16(x1[2], x1[3]);
                        *(u32x4*)(XB + off) = w; } }
                ssv[m2] = ss; }
#pragma unroll
            for (int m2 = 0; m2 < 2; ++m2) { float ss = sum_fq4(ssv[m2]);
                if (fq == 0) ssq[(size_t)(row0 + ai * HALF + (2 * mh + m2) * 16) * 32 + 4 * u.pn + wc] = ss; }
            asm volatile("" ::: "memory");
        }
    }
};
struct GroupOrder {
    int nwg, G, c, per;
    __device__ __forceinline__ bool next(int i, Unit& u) const { const long L = (long)i * G + c; if (L >= nwg) return false; u.pm = (int)L; u.pn = (int)L / per; u.seg = 0; return true; }
    __device__ __forceinline__ void a_ready(const Unit&) const {}
    __device__ __forceinline__ void done(const Unit&) const {}
};
struct EpiSsmS { static constexpr bool PERM = true, AFTER_DRAIN = false, ROWMAP = false, TWOSEG = false;
    bf16_t* S;
    __device__ __forceinline__ void operator()(const f32x4 (&acc)[2][2][4][2], const Unit& u, int wr, int wc, int fr, int fq) const {
        const int row0 = u.pm * BM + wr * 64 + fr, col0 = wc * 32 + 8 * fq;
#pragma unroll
        for (int ai = 0; ai < 2; ++ai)
#pragma unroll
            for (int m = 0; m < 4; ++m) { const f32x4 a0 = acc[ai][0][m][0], a1 = acc[ai][0][m][1];
                u32x4 w; w.x = cvt_pk_bf16(a0[0], a0[1]); w.y = cvt_pk_bf16(a0[2], a0[3]); w.z = cvt_pk_bf16(a1[0], a1[1]); w.w = cvt_pk_bf16(a1[2], a1[3]);
                *(u32x4*)(S + (size_t)(row0 + ai * HALF + m * 16) * 128 + col0) = w; }
    }
};
struct EpiSsmY { static constexpr bool PERM = true, AFTER_DRAIN = false, ROWMAP = false, TWOSEG = false;
    bf16_t* Y;
    __device__ __forceinline__ void operator()(const f32x4 (&acc)[2][2][4][2], const Unit& u, int wr, int wc, int fr, int fq) const {
        const int g = u.pn, row0 = u.pm * BM - g * 2048 + wr * 64 + fr, col0 = wc * 32 + 8 * fq;
#pragma unroll
        for (int ai = 0; ai < 2; ++ai)
#pragma unroll
            for (int m = 0; m < 4; ++m) { const int R = row0 + ai * HALF + m * 16;
#pragma unroll
                for (int bj = 0; bj < 2; ++bj) { const int col = col0 + bj * HALF, j = col >> 4, o8 = col & 8; const f32x4 a0 = acc[ai][bj][m][0], a1 = acc[ai][bj][m][1];
                    u32x4 w; w.x = cvt_pk_bf16(gelu_t(a0[0]), gelu_t(a0[1])); w.y = cvt_pk_bf16(gelu_t(a0[2]), gelu_t(a0[3])); w.z = cvt_pk_bf16(gelu_t(a1[0]), gelu_t(a1[1])); w.w = cvt_pk_bf16(gelu_t(a1[2]), gelu_t(a1[3]));
                    *(u32x4*)(Y + (size_t)(16 * R + j) * 1024 + 16 * g + o8) = w; } }
    }
};

__device__ __forceinline__ float dpp_shr1_z(float x) { return __builtin_bit_cast(float, __builtin_amdgcn_mov_dpp(__builtin_bit_cast(int, x), 0x111, 0xF, 0xF, true)); }
__device__ __forceinline__ float dpp_shr1_w(float x, float prevblk) { const int o = __builtin_amdgcn_mov_dpp(__builtin_bit_cast(int, prevblk), 0x121, 0xF, 0xF, true);
    return __builtin_bit_cast(float, __builtin_amdgcn_update_dpp(o, __builtin_bit_cast(int, x), 0x111, 0xF, 0xF, false)); }
struct EpiUpConv { static constexpr bool PERM = true, AFTER_DRAIN = false, ROWMAP = true, TWOSEG = false;
    bf16_t* Gm; bf16_t* RAW; RstdTab rt; const float* cw; const float* cb;
    __device__ __forceinline__ void operator()(const f32x4 (&acc)[2][2][4][2], const Unit& u, int wr, int wc, int fr, int fq) const {
        constexpr int DFF = 5504, NUP = 11008;
        const int tok0 = u.pm * BM + 128 * wr + 4 * fr, f0 = u.pn * 128 + wc * 32 + 8 * fq;
        const PG8_LAS float* tb_ = rt.base(u.pm);
        float rs[2][4];
#pragma unroll
        for (int ai = 0; ai < 2; ++ai)
#pragma unroll
            for (int m = 0; m < 4; ++m) rs[ai][m] = rt.get(tb_, tok0 + 64 * ai + m, fq);
        typedef unsigned u32x2g __attribute__((ext_vector_type(2))); u32x2g gst[2][4];
#pragma unroll
        for (int n = 0; n < 2; ++n) {
            const int f = f0 + 4 * n;
            const f32x4 w0a = *(const f32x4*)(cw + f), w1a = *(const f32x4*)(cw + NUP + f), w2a = *(const f32x4*)(cw + 2 * NUP + f), cba = *(const f32x4*)(cb + f);
            const f32x4 w0v = *(const f32x4*)(cw + DFF + f), w1v = *(const f32x4*)(cw + NUP + DFF + f), w2v = *(const f32x4*)(cw + 2 * NUP + DFF + f), cbv = *(const f32x4*)(cb + DFF + f);
            f32x4 pa2 = {0.f, 0.f, 0.f, 0.f}, pa3 = pa2, pv2 = pa2, pv3 = pa2;
#pragma unroll
            for (int ai = 0; ai < 2; ++ai) {
                f32x4 pa[4], pv[4];
#pragma unroll
                for (int m = 0; m < 4; ++m) { pa[m] = acc[ai][0][m][n] * rs[ai][m]; pv[m] = acc[ai][1][m][n] * rs[ai][m]; }
                f32x4 x1a, x2a, x1v, x2v;
#pragma unroll
                for (int e = 0; e < 4; ++e) {
                    if (ai == 0) { x1a[e] = dpp_shr1_z(pa[3][e]); x2a[e] = dpp_shr1_z(pa[2][e]); x1v[e] = dpp_shr1_z(pv[3][e]); x2v[e] = dpp_shr1_z(pv[2][e]); }
                    else { x1a[e] = dpp_shr1_w(pa[3][e], pa3[e]); x2a[e] = dpp_shr1_w(pa[2][e], pa2[e]); x1v[e] = dpp_shr1_w(pv[3][e], pv3[e]); x2v[e] = dpp_shr1_w(pv[2][e], pv2[e]); } }
                { const bool first = (ai == 0) && (fr == 0), last = (ai == 1) && (fr == 15);
                  if (first || last) { bf16_t* rp = RAW + ((size_t)u.pm * 8 + 4 * wr + 2 * ai) * NUP + f;
                      const f32x4 a0 = first ? pa[0] : pa[2], a1 = first ? pa[1] : pa[3], v0 = first ? pv[0] : pv[2], v1 = first ? pv[1] : pv[3];
                      typedef unsigned u32x2 __attribute__((ext_vector_type(2)));
                      u32x2 t; t.x = cvt_pk_bf16(a0[0], a0[1]); t.y = cvt_pk_bf16(a0[2], a0[3]); *(u32x2*)(rp) = t;
                      t.x = cvt_pk_bf16(a1[0], a1[1]); t.y = cvt_pk_bf16(a1[2], a1[3]); *(u32x2*)(rp + NUP) = t;
                      t.x = cvt_pk_bf16(v0[0], v0[1]); t.y = cvt_pk_bf16(v0[2], v0[3]); *(u32x2*)(rp + DFF) = t;
                      t.x = cvt_pk_bf16(v1[0], v1[1]); t.y = cvt_pk_bf16(v1[2], v1[3]); *(u32x2*)(rp + NUP + DFF) = t; } }
#pragma unroll
                for (int m = 0; m < 4; ++m) {
                    const f32x4 s1a = (m == 0) ? x1a : pa[m - 1], s2a = (m == 0) ? x2a : (m == 1) ? x1a : pa[m - 2];
                    const f32x4 s1v = (m == 0) ? x1v : pv[m - 1], s2v = (m == 0) ? x2v : (m == 1) ? x1v : pv[m - 2];
                    const f32x4 ca = cba + w0a * s2a + w1a * s1a + w2a * pa[m], cv = cbv + w0v * s2v + w1v * s1v + w2v * pv[m];
                    typedef unsigned u32x2 __attribute__((ext_vector_type(2)));
                    const f32x4 gv_ = gelu_mul4(ca, cv); u32x2 t; t.x = cvt_pk_bf16(gv_[0], gv_[1]); t.y = cvt_pk_bf16(gv_[2], gv_[3]);
                    if (n == 0) gst[ai][m] = t;
                    else { u32x4 w4; w4.x = gst[ai][m].x; w4.y = gst[ai][m].y; w4.z = t.x; w4.w = t.y; *(u32x4*)(Gm + (size_t)(tok0 + 64 * ai + m) * DFF + f0) = w4; } }
                pa2 = pa[2]; pa3 = pa[3]; pv2 = pv[2]; pv3 = pv[3];
            }
        }
    }
};

struct EpiWin { static constexpr bool PERM = true, AFTER_DRAIN = false, ROWMAP = false, TWOSEG = false;
    bf16_t* O; bf16_t* UC; RstdTab rt; const float* qg; const float* kg; float qscale;
    __device__ __forceinline__ void operator()(const f32x4 (&acc)[2][2][4][2], const Unit& u, int wr, int wc, int fr, int fq) const {
        const int row0 = u.pm * BM + wr * 64 + fr; const PG8_LAS float* tb_ = rt.base(u.pm);
        if (u.pn < 8) {
            const float* g = (u.pn < 4) ? qg : kg; const float sc0 = (u.pn < 4) ? qscale : 1.0f;
            f32x4 gv[2][2];
#pragma unroll
            for (int bj = 0; bj < 2; ++bj)
#pragma unroll
                for (int n = 0; n < 2; ++n) gv[bj][n] = *(const f32x4*)(g + 32 * bj + 8 * fq + 4 * n) * sc0;
#pragma unroll
            for (int ai = 0; ai < 2; ++ai)
#pragma unroll
                for (int m = 0; m < 4; ++m) { const int row = row0 + ai * HALF + m * 16; const float rs = rt.get(tb_, row, fq);
                    float sa = 0.f;
#pragma unroll
                    for (int bj = 0; bj < 2; ++bj)
#pragma unroll
                        for (int n = 0; n < 2; ++n) { const f32x4 a = acc[ai][bj][m][n]; sa += (a[0] * a[0] + a[1] * a[1]) + (a[2] * a[2] + a[3] * a[3]); }
                    sa = sum_fq4(sa);
                    const float sc = rs * __builtin_amdgcn_rsqf(rs * rs * sa * (1.0f / 64.0f) + 1e-6f);
#pragma unroll
                    for (int bj = 0; bj < 2; ++bj) { const f32x4 v0 = acc[ai][bj][m][0] * sc * gv[bj][0], v1 = acc[ai][bj][m][1] * sc * gv[bj][1];
                        u32x4 w; w.x = cvt_pk_bf16(v0[0], v0[1]); w.y = cvt_pk_bf16(v0[2], v0[3]); w.z = cvt_pk_bf16(v1[0], v1[1]); w.w = cvt_pk_bf16(v1[2], v1[3]);
                        *(u32x4*)(O + (size_t)row * 8192 + u.pn * BM + 64 * wc + 32 * bj + 8 * fq) = w; } }
        } else if (u.pn >= 12 && u.pn < 16) {
#pragma unroll
            for (int ai = 0; ai < 2; ++ai)
#pragma unroll
                for (int m = 0; m < 4; ++m) { const int row = row0 + ai * HALF + m * 16; const float s = rt.get(tb_, row, fq);
#pragma unroll
                    for (int bj = 0; bj < 2; ++bj) { const f32x4 v0 = acc[ai][bj][m][0] * s, v1 = acc[ai][bj][m][1] * s;
                        u32x4 w; w.x = cvt_pk_bf16(v0[0], v0[1]); w.y = cvt_pk_bf16(v0[2], v0[3]); w.z = cvt_pk_bf16(v1[0], v1[1]); w.w = cvt_pk_bf16(v1[2], v1[3]);
                        const int c = (u.pn - 12) * BM + bj * HALF + wc * 32 + 8 * fq, g = c >> 4;
                        *(u32x4*)(UC + ((size_t)g * 2048 + (row >> 4)) * 384 + 16 * (row & 15) + (c & 15)) = w; } }
        } else if (u.pn >= 16) {
            const int c0 = (u.pn - 16) * HALF + wc * 32 + 8 * fq;
#pragma unroll
            for (int ai = 0; ai < 2; ++ai)
#pragma unroll
                for (int m = 0; m < 4; ++m) { const int row = row0 + ai * HALF + m * 16; const float s = -1.4426950408889634f * rt.get(tb_, row, fq);
                    unsigned qa[2] = {0u, 0u}, qs[2] = {0u, 0u};
#pragma unroll
                    for (int n = 0; n < 2; ++n)
#pragma unroll
                        for (int e = 0; e < 4; ++e) { const float ea = __builtin_amdgcn_exp2f(s * acc[ai][0][m][n][e]), es = __builtin_amdgcn_exp2f(s * acc[ai][1][m][n][e]);
                            const float va = __builtin_amdgcn_rcpf(1.0f + ea), vs = __builtin_amdgcn_rcpf(1.0f + es);
                            const unsigned ia = (unsigned)(va * 255.0f + 0.5f); unsigned is = (unsigned)(vs * 255.0f + 0.5f); is = is < 1u ? 1u : is;
                            qa[n] |= ia << (8 * e); qs[n] |= is << (8 * e); }
                    u32x4 w; w.x = qa[0]; w.y = qa[1]; w.z = qs[0]; w.w = qs[1];
                    *(u32x4*)((unsigned char*)(O + (size_t)row * 8192 + 4096) + (size_t)(c0 >> 3) * 16) = w; }
        } else {
            const int col0 = u.pn * BM + wc * 32 + 8 * fq;
#pragma unroll
            for (int ai = 0; ai < 2; ++ai)
#pragma unroll
                for (int m = 0; m < 4; ++m) { const int row = row0 + ai * HALF + m * 16; const float s = rt.get(tb_, row, fq); bf16_t* rowp = O + (size_t)row * 8192 + col0;
#pragma unroll
                    for (int bj = 0; bj < 2; ++bj) { const f32x4 v0 = acc[ai][bj][m][0] * s, v1 = acc[ai][bj][m][1] * s;
                        u32x4 w; w.x = cvt_pk_bf16(v0[0], v0[1]); w.y = cvt_pk_bf16(v0[2], v0[3]); w.z = cvt_pk_bf16(v1[0], v1[1]); w.w = cvt_pk_bf16(v1[2], v1[3]);
                        *(u32x4*)(rowp + bj * HALF) = w; } }
        }
    }
};


struct TwoSegOrder {
    StaticOrder base;
    __device__ __forceinline__ bool next(int i, Unit& u) const { if (!base.next(i >> 1, u)) return false; u.seg = i & 1; return true; }
    __device__ __forceinline__ void a_ready(const Unit&) const {}
    __device__ __forceinline__ void done(const Unit&) const {}
};
__device__ __forceinline__ f32x4 ub4(unsigned w) { return (f32x4){(float)(w & 0xffu), (float)((w >> 8) & 0xffu), (float)((w >> 16) & 0xffu), (float)(w >> 24)}; }
__device__ __forceinline__ f32x4 rcp4(f32x4 d) { return (f32x4){__builtin_amdgcn_rcpf(d[0]), __builtin_amdgcn_rcpf(d[1]), __builtin_amdgcn_rcpf(d[2]), __builtin_amdgcn_rcpf(d[3])}; }
struct EpiGateF { static constexpr bool PERM = true, AFTER_DRAIN = false, ROWMAP = false, TWOSEG = true;
    bf16_t* O; int ldo; const unsigned char* GT; int ldgB;
    __device__ __forceinline__ void mid(f32x4 (&acc)[2][2][4][2], const Unit& u, int wr, int wc, int fr, int fq) const {
        const int row0 = u.pm * BM + wr * 64 + fr, col0 = u.pn * BM + wc * 32 + 8 * fq;
#pragma unroll
        for (int ai = 0; ai < 2; ++ai) {
            u32x4 gv[4][2];
#pragma unroll
            for (int m = 0; m < 4; ++m)
#pragma unroll
                for (int bj = 0; bj < 2; ++bj) gv[m][bj] = *(const u32x4*)(GT + (size_t)(row0 + ai * HALF + m * 16) * ldgB + (size_t)((col0 + bj * HALF) >> 3) * 16);
#pragma unroll
            for (int m = 0; m < 4; ++m)
#pragma unroll
                for (int bj = 0; bj < 2; ++bj) { const u32x4 g = gv[m][bj];
                    acc[ai][bj][m][0] = acc[ai][bj][m][0] * (ub4(g.x) * rcp4(ub4(g.z)));
                    acc[ai][bj][m][1] = acc[ai][bj][m][1] * (ub4(g.y) * rcp4(ub4(g.w))); }
        }
    }
    __device__ __forceinline__ void operator()(const f32x4 (&acc)[2][2][4][2], const Unit& u, int wr, int wc, int fr, int fq) const {
        typedef unsigned u32x2l __attribute__((ext_vector_type(2)));
        const int row0 = u.pm * BM + wr * 64 + fr, col0 = u.pn * BM + wc * 32 + 8 * fq;
#pragma unroll
        for (int ai = 0; ai < 2; ++ai) {
            u32x2l gv[4][2];
#pragma unroll
            for (int m = 0; m < 4; ++m)
#pragma unroll
                for (int bj = 0; bj < 2; ++bj) gv[m][bj] = *(const u32x2l*)(GT + (size_t)(row0 + ai * HALF + m * 16) * ldgB + (size_t)((col0 + bj * HALF) >> 3) * 16 + 8);
            asm volatile("" ::: "memory");
#pragma unroll
            for (int m = 0; m < 4; ++m)
#pragma unroll
                for (int bj = 0; bj < 2; ++bj) { const u32x2l g = gv[m][bj]; const f32x4 a0 = acc[ai][bj][m][0] * (ub4(g.x) * (1.0f / 255.0f)), a1 = acc[ai][bj][m][1] * (ub4(g.y) * (1.0f / 255.0f));
                    u32x4 w; w.x = cvt_pk_bf16(a0[0], a0[1]); w.y = cvt_pk_bf16(a0[2], a0[3]); w.z = cvt_pk_bf16(a1[0], a1[1]); w.w = cvt_pk_bf16(a1[2], a1[3]);
                    *(u32x4*)(O + (size_t)(row0 + ai * HALF + m * 16) * ldo + col0 + bj * HALF) = w; }
            asm volatile("" ::: "memory");
        }
    }
};

template <class Epi, class Sched, bool ALIGN_EPI = false, bool SP2 = false>
__device__ __forceinline__ void gemm_phase(PG8_LAS unsigned char* lds, const Gemm g, const Sched& S, const Epi& E) {
    int tid_ = threadIdx.x; asm volatile("" : "+v"(tid_));
    const int tid = tid_, wid = __builtin_amdgcn_readfirstlane(tid >> 6), lane = tid & 63, wr = wid >> 2, wc = wid & 3, fr = lane & 15, fq = lane >> 4;
    const int K = g.K, nt = K / BK;
    unsigned voffA[2], voffB[2];
#pragma unroll
    for (int i = 0; i < 2; ++i) { int R, C; stage_rc(tid * 16 + i * 8192, R, C); const int Rb = Epi::PERM ? ((R & ~31) + perm32(R & 31)) : R;
        const int Ra = Epi::ROWMAP ? (128 * (R >> 6) + 4 * (R & 15) + ((R >> 4) & 3)) : R;
        voffA[i] = (unsigned)(Ra * g.lda + C) * 2u; voffB[i] = (unsigned)(Rb * g.ldb + C) * 2u; }
    const size_t kstep = (size_t)(BK * 2);
    const size_t hstepA = (size_t)(Epi::ROWMAP ? 64 : HALF) * g.lda * 2, hstepB = (size_t)HALF * g.ldb * 2;
    const size_t tstepA = (size_t)BM * g.lda * 2, tstepB = 2 * hstepB;
    const unsigned ldsw = (unsigned)wid * 1024u;
    const int aoff = lds_byte(wr * 64 + fr, fq * 8), boff = lds_byte(wc * 32 + fr, fq * 8);
#define PG8_SA(b, h) (((b) * 2 + (h)) * HTB)
#define PG8_SB(b, h) ((4 + (b) * 2 + (h)) * HTB)
#define PG8_STAGE(bufoff, gbase, voff) do { _Pragma("unroll") for (int _i = 0; _i < 2; ++_i) \
        __builtin_amdgcn_global_load_lds((const unsigned*)((const char*)(gbase) + (voff)[_i]), (PG8_LAS unsigned*)(lds + (bufoff) + ldsw + _i * 8192), 16, 0, 0); } while (0)
#define PG8_LDA(dst, b, h) do { _Pragma("unroll") for (int m = 0; m < 4; ++m) _Pragma("unroll") for (int k = 0; k < 2; ++k) dst[m][k] = *(const PG8_LAS bf16x8*)(lds + PG8_SA(b, h) + aoff + m * 2048 + k * 1024); } while (0)
#define PG8_LDB(dst, b, h) do { _Pragma("unroll") for (int n = 0; n < 2; ++n) _Pragma("unroll") for (int k = 0; k < 2; ++k) dst[n][k] = *(const PG8_LAS bf16x8*)(lds + PG8_SB(b, h) + boff + n * 2048 + k * 1024); } while (0)
#define PG8_MMA(ai, bj, At, Bt) do { __builtin_amdgcn_s_setprio(1); _Pragma("unroll") for (int m = 0; m < 4; ++m) _Pragma("unroll") for (int n = 0; n < 2; ++n) _Pragma("unroll") for (int k = 0; k < 2; ++k) \
        acc[ai][bj][m][n] = __builtin_amdgcn_mfma_f32_16x16x32_bf16(Bt[n][k], At[m][k], acc[ai][bj][m][n], 0, 0, 0); __builtin_amdgcn_s_setprio(0); } while (0)
#define PG8_WAIT_V(n) asm volatile("s_waitcnt vmcnt(" #n ")" ::: "memory")
#define PG8_WAIT_L(n) asm volatile("s_waitcnt lgkmcnt(" #n ")" ::: "memory")
#define PG8_BAR __builtin_amdgcn_s_barrier()
#define PG8_SCHED __builtin_amdgcn_sched_barrier(0)
    Unit cur, nxt; int ui = 0;
    if (!S.next(0, cur)) return;
    f32x4 acc[2][2][4][2];
#pragma unroll
    for (int a = 0; a < 2; ++a)
#pragma unroll
        for (int b = 0; b < 2; ++b)
#pragma unroll
            for (int m = 0; m < 4; ++m)
#pragma unroll
                for (int n = 0; n < 2; ++n) acc[a][b][m][n] = (f32x4){0.f, 0.f, 0.f, 0.f};
    bf16x8 At[4][2], B0[2][2], B1[2][2];
    const char* cA = (const char*)((Epi::TWOSEG && cur.seg) ? g.A2 : g.A) + (size_t)cur.pm * tstepA; const char* cB = (const char*)((Epi::TWOSEG && cur.seg) ? g.Bt2 : g.Bt) + (size_t)cur.pn * tstepB;
    S.a_ready(cur);
    if constexpr (SP2) {
        PG8_STAGE(PG8_SB(0, 0), cB, voffB); PG8_STAGE(PG8_SB(0, 1), cB + hstepB, voffB); PG8_STAGE(PG8_SA(0, 0), cA, voffA); PG8_STAGE(PG8_SA(0, 1), cA + hstepA, voffA);
        if (wr == 1) PG8_BAR;
        PG8_WAIT_V(2); PG8_BAR;
        PG8_STAGE(PG8_SB(1, 0), cB + kstep, voffB); PG8_STAGE(PG8_SA(1, 0), cA + kstep, voffA); PG8_STAGE(PG8_SB(1, 1), cB + hstepB + kstep, voffB);
        PG8_WAIT_V(6); PG8_BAR;
    } else {
        PG8_STAGE(PG8_SB(0, 0), cB, voffB); PG8_STAGE(PG8_SA(0, 0), cA, voffA); PG8_STAGE(PG8_SB(0, 1), cB + hstepB, voffB); PG8_STAGE(PG8_SA(0, 1), cA + hstepA, voffA);
        if (wr == 1) PG8_BAR;
        PG8_WAIT_V(4); PG8_BAR;
        PG8_STAGE(PG8_SB(1, 0), cB + kstep, voffB); PG8_STAGE(PG8_SA(1, 0), cA + kstep, voffA); PG8_STAGE(PG8_SB(1, 1), cB + hstepB + kstep, voffB);
        PG8_WAIT_V(6); PG8_BAR;
    }
    for (;;) {
        const bool has_next = S.next(ui + 1, nxt);
        const char* nA = has_next ? (const char*)((Epi::TWOSEG && nxt.seg) ? g.A2 : g.A) + (size_t)nxt.pm * tstepA : cA; const char* nB = has_next ? (const char*)((Epi::TWOSEG && nxt.seg) ? g.Bt2 : g.Bt) + (size_t)nxt.pn * tstepB : cB;
        for (int t = 0; t < nt; t += 2) {
            const bool last = (t == nt - 2);
            const char* a1 = cA + (size_t)(t + 1) * kstep;
            const char* a2 = last ? nA : cA + (size_t)(t + 2) * kstep; const char* b2 = last ? nB : cB + (size_t)(t + 2) * kstep;
            const char* a3 = a2 + kstep; const char* b3 = b2 + kstep;
            if (last && has_next) S.a_ready(nxt);
            if constexpr (SP2) {
            PG8_LDB(B0, 0, 0); PG8_LDB(B1, 0, 1); PG8_SCHED; PG8_LDA(At, 0, 0); PG8_STAGE(PG8_SA(1, 1), a1 + hstepA, voffA);
            PG8_WAIT_V(8); PG8_WAIT_L(0); PG8_BAR; PG8_MMA(0, 0, At, B0); PG8_MMA(0, 1, At, B1); PG8_BAR; PG8_SCHED;
            PG8_LDA(At, 0, 1); PG8_STAGE(PG8_SB(0, 0), b2, voffB); PG8_STAGE(PG8_SB(0, 1), b2 + hstepB, voffB); PG8_STAGE(PG8_SA(0, 0), a2, voffA);
            PG8_WAIT_V(8); PG8_WAIT_L(0); PG8_BAR; PG8_MMA(1, 0, At, B0); PG8_MMA(1, 1, At, B1); PG8_BAR; PG8_SCHED;
            PG8_LDB(B0, 1, 0); PG8_LDB(B1, 1, 1); PG8_SCHED; PG8_LDA(At, 1, 0); PG8_STAGE(PG8_SA(0, 1), a2 + hstepA, voffA);
            PG8_WAIT_V(8); PG8_WAIT_L(0); PG8_BAR; PG8_MMA(0, 0, At, B0); PG8_MMA(0, 1, At, B1); PG8_BAR; PG8_SCHED;
            PG8_LDA(At, 1, 1); PG8_STAGE(PG8_SB(1, 0), b3, voffB); PG8_STAGE(PG8_SB(1, 1), b3 + hstepB, voffB); PG8_STAGE(PG8_SA(1, 0), a3, voffA);
            PG8_WAIT_V(8); PG8_WAIT_L(0); PG8_BAR; PG8_MMA(1, 0, At, B0); PG8_MMA(1, 1, At, B1); PG8_BAR; PG8_SCHED;
            } else {
            PG8_LDB(B0, 0, 0); PG8_SCHED; PG8_LDA(At, 0, 0); PG8_STAGE(PG8_SA(1, 1), a1 + hstepA, voffA);
            PG8_WAIT_L(8); PG8_BAR; PG8_WAIT_L(0); PG8_MMA(0, 0, At, B0); PG8_BAR; PG8_SCHED;
            PG8_LDB(B1, 0, 1); PG8_STAGE(PG8_SB(0, 0), b2, voffB);
            PG8_BAR; PG8_WAIT_L(0); PG8_MMA(0, 1, At, B1); PG8_BAR;
            PG8_LDA(At, 0, 1); PG8_STAGE(PG8_SA(0, 0), a2, voffA);
            PG8_BAR; PG8_WAIT_L(0); PG8_MMA(1, 0, At, B0); PG8_BAR; PG8_SCHED;
            PG8_STAGE(PG8_SB(0, 1), b2 + hstepB, voffB);
            PG8_WAIT_V(6); PG8_BAR; PG8_MMA(1, 1, At, B1); PG8_BAR;
            PG8_LDB(B0, 1, 0); PG8_SCHED; PG8_LDA(At, 1, 0); PG8_STAGE(PG8_SA(0, 1), a2 + hstepA, voffA);
            PG8_WAIT_L(8); PG8_BAR; PG8_WAIT_L(0); PG8_MMA(0, 0, At, B0); PG8_BAR; PG8_SCHED;
            PG8_LDB(B1, 1, 1); PG8_STAGE(PG8_SB(1, 0), b3, voffB);
            PG8_BAR; PG8_WAIT_L(0); PG8_MMA(0, 1, At, B1); PG8_BAR;
            PG8_LDA(At, 1, 1); PG8_STAGE(PG8_SA(1, 0), a3, voffA);
            PG8_BAR; PG8_WAIT_L(0); PG8_MMA(1, 0, At, B0); PG8_BAR; PG8_SCHED;
            PG8_STAGE(PG8_SB(1, 1), b3 + hstepB, voffB);
            PG8_WAIT_V(6); PG8_BAR; PG8_MMA(1, 1, At, B1); PG8_BAR;
            }
        }
        if constexpr (ALIGN_EPI) { if (wr == 0) PG8_BAR; }
        const bool midseg = Epi::TWOSEG && cur.seg == 0;
        if constexpr (!Epi::AFTER_DRAIN) { if constexpr (Epi::TWOSEG) { if (midseg) E.mid(acc, cur, wr, wc, fr, fq); else { E(acc, cur, wr, wc, fr, fq); S.done(cur); } } else { E(acc, cur, wr, wc, fr, fq); S.done(cur); } }
        if (!has_next) break;
        if (!midseg)
#pragma unroll
        for (int a = 0; a < 2; ++a)
#pragma unroll
            for (int b = 0; b < 2; ++b)
#pragma unroll
                for (int m = 0; m < 4; ++m)
#pragma unroll
                    for (int n = 0; n < 2; ++n) acc[a][b][m][n] = (f32x4){0.f, 0.f, 0.f, 0.f};
        cur = nxt; cA = nA; cB = nB; ++ui;
        if constexpr (ALIGN_EPI) { if (wr == 1) PG8_BAR; }
    }
    PG8_WAIT_V(0);
    if constexpr (!ALIGN_EPI) { if (wr == 0) PG8_BAR; }
    PG8_BAR;
    if constexpr (Epi::AFTER_DRAIN) { E.fused(acc, cur, wr, wc, fr, fq, lds, wid, lane); S.done(cur); }
#undef PG8_SA
#undef PG8_SB
#undef PG8_STAGE
#undef PG8_LDA
#undef PG8_LDB
#undef PG8_MMA
#undef PG8_WAIT_V
#undef PG8_WAIT_L
#undef PG8_BAR
#undef PG8_SCHED
}
}
constexpr int NWAVES = 8, NTHR = NWAVES * 64;
constexpr int NL = 4, NB = 16, SEQ = 2048, DM = 2048, MR = NB * SEQ;
constexpr int NIN = 8192, DFF = 5504, NUP = 2 * DFF, DS = 1024, NG = 64, NPS = 64, NIS = 16, NH = 8;
constexpr int OFF_K = 1024, OFF_V = 2048, OFF_U = 3072, OFF_GA = 4096, OFF_GS = 6144;
constexpr float EPS = 1e-6f, LOG2E = 1.4426950408889634f, QSCALE = 0.125f * LOG2E;
constexpr int PH_PER_LAYER = 9, N_PHASES = 1 + NL * PH_PER_LAYER;

constexpr size_t MiB = 1u << 20;
constexpr size_t WS_CTL = 0, CTL_ZERO_BYTES = 1 * MiB;
constexpr size_t WS_WIN = 2 * MiB, WS_WGLU = 34 * MiB, WS_WBA = 36 * MiB, WS_WBS = 40 * MiB, WS_WOUT = 44 * MiB, WS_WUP = 52 * MiB, WS_WDN = 95 * MiB;
constexpr size_t WS_RSTD = 1280 * MiB;
constexpr size_t WS_XB = 120 * MiB;
constexpr size_t WS_PROJ = 248 * MiB;
constexpr size_t WS_YG = 1104 * MiB, WS_Y2 = 1284 * MiB, WS_ON = 888 * MiB;
constexpr size_t WS_MIX = 952 * MiB;
constexpr size_t WS_RAW = 248 * MiB;
constexpr size_t WS_G = 936 * MiB;
constexpr size_t WS_BTY = 1080 * MiB, WS_BTS = 1092 * MiB, WS_KTAB = 1100 * MiB;
constexpr size_t WS_S = 824 * MiB;
constexpr size_t WS_UCAT = 1168 * MiB;
constexpr size_t WS_END = 1348 * MiB;
constexpr int CW_BAR = 4096;

constexpr int RING_BYTES = 131072, LDSCTL_OFF = RING_BYTES, MISC_OFF = LDSCTL_OFF + 320, LDS_BYTES = 147456;

#define GAS __attribute__((address_space(1)))
#define LAS __attribute__((address_space(3)))
typedef unsigned short bf16;
typedef unsigned v4u __attribute__((ext_vector_type(4)));
typedef float f32x4 __attribute__((ext_vector_type(4)));
typedef short bf16x8 __attribute__((ext_vector_type(8)));
typedef GAS unsigned gu32;
typedef GAS unsigned long long gu64;
#define RLX_AGENT __ATOMIC_RELAXED, __HIP_MEMORY_SCOPE_AGENT
#define LDS_WAIT() asm volatile("s_waitcnt lgkmcnt(0)" ::: "memory")
#define VM_WAIT() asm volatile("s_waitcnt vmcnt(0)" ::: "memory")
__device__ __forceinline__ unsigned long long rt() { return __builtin_amdgcn_s_memrealtime(); }
__device__ __forceinline__ unsigned f2bf(float f) { unsigned u = __builtin_bit_cast(unsigned, f); return (u + 0x7fffu + ((u >> 16) & 1u)) >> 16; }
__device__ __forceinline__ unsigned pk2(float lo, float hi) { return f2bf(lo) | (f2bf(hi) << 16); }

#define XB_TMO      128
#define XB_XCNT(j)  (256  + 64 * (j))
#define XB_XSUB(j)  (1280 + 64 * (j))
#define XB_XGEN(j)  (2304 + 64 * (j))
#define XB_TOP      3328
#define XB_TOPGEN   3392
#define XCD_BAR_WORDS 3456
#define XB_SPIN_CAP (1u << 18)

__device__ __forceinline__ unsigned xb_ld(unsigned* p)              { return __hip_atomic_load(p, __ATOMIC_RELAXED, __HIP_MEMORY_SCOPE_AGENT); }
__device__ __forceinline__ unsigned xb_add(unsigned* p, unsigned v) { return __hip_atomic_fetch_add(p, v, __ATOMIC_RELAXED, __HIP_MEMORY_SCOPE_AGENT); }
__device__ __forceinline__ unsigned xb_xcc_id() { return (unsigned)__builtin_amdgcn_s_getreg((3 << 11) | 20) & 0xFu; }
#define XB_SPIN(cond, bar) do { unsigned _sp = 0; while (cond) { __builtin_amdgcn_s_sleep(1); \
    if ((++_sp & 255u) == 0u) { if (xb_ld(&(bar)[XB_TMO])) break; if (_sp > XB_SPIN_CAP) { atomicAdd(&(bar)[XB_TMO], 1u); break; } } } } while (0)

struct XcdBarrier {
    unsigned* bar; unsigned x;
    volatile LAS unsigned* st;
};

__device__ __forceinline__ XcdBarrier xcd_barrier_post(unsigned* bar, volatile LAS unsigned* st) {
    XcdBarrier b; b.bar = bar; b.x = xb_xcc_id(); b.st = st;
    if (threadIdx.x == 0) st[3] = xb_add(&bar[XB_XCNT(b.x)], 1u);
    return b;
}
__device__ __forceinline__ void xcd_barrier_complete(unsigned* bar, unsigned x, unsigned& nloc, unsigned& nx, unsigned& even) {
    const unsigned G = gridDim.x * gridDim.y * gridDim.z;
    unsigned sum, cnt, mine, ev, sp = 0u;
    for (;;) {
        sum = 0u; cnt = 0u; mine = 0u; ev = (G % 8u == 0u) ? 1u : 0u;
#pragma unroll
        for (unsigned j = 0; j < 16; ++j) { const unsigned c = xb_ld(&bar[XB_XCNT(j)]); sum += c; cnt += (c > 0u) ? 1u : 0u; mine = (j == x) ? c : mine; if (j < 8u && c * 8u != G) ev = 0u; }
        if (sum == G) break;
        __builtin_amdgcn_s_sleep(1);
        if ((++sp & 255u) == 0u) { if (xb_ld(&bar[XB_TMO])) break; if (sp > XB_SPIN_CAP) { atomicAdd(&bar[XB_TMO], 1u); break; } }
    }
    nloc = mine > 0u ? mine : 1u; nx = cnt > 0u ? cnt : 1u; even = (sum == G) ? ev : 0u;
}

__device__ __forceinline__ void xcd_barrier(const XcdBarrier& b) {
    asm volatile("s_waitcnt vmcnt(0)" ::: "memory");
    __syncthreads();
    if (threadIdx.x == 0) {
        unsigned* bar = b.bar;
        __builtin_amdgcn_s_waitcnt(0);
        unsigned nloc = b.st[0], nx = b.st[1];
        if (nloc == 0u) { unsigned even; xcd_barrier_complete(bar, b.x, nloc, nx, even); b.st[0] = nloc; b.st[1] = nx; b.st[2] = even; }
        const unsigned old = xb_add(&bar[XB_XSUB(b.x)], 1u);
        const unsigned gen = old / nloc;
        if (old + 1u == (gen + 1u) * nloc) {
            __builtin_amdgcn_fence(__ATOMIC_RELEASE, "agent");
            asm volatile("s_waitcnt vmcnt(0)" ::: "memory");
            const unsigned og = xb_add(&bar[XB_TOP], 1u);
            const unsigned tg = og / nx;
            if (og + 1u == (tg + 1u) * nx) xb_add(&bar[XB_TOPGEN], 1u);
            else XB_SPIN(xb_ld(&bar[XB_TOPGEN]) == tg, bar);
            __builtin_amdgcn_fence(__ATOMIC_ACQUIRE, "agent");
            xb_add(&bar[XB_XGEN(b.x)], 1u);
            asm volatile("s_waitcnt vmcnt(0)" ::: "memory");
        } else {
            XB_SPIN(xb_ld(&bar[XB_XGEN(b.x)]) == gen, bar);
            __builtin_amdgcn_fence(__ATOMIC_ACQUIRE, "agent");
            asm volatile("s_waitcnt vmcnt(0)" ::: "memory");
        }
    }
    __syncthreads();
}
__device__ __forceinline__ void xcd_barrier_local(const XcdBarrier& b) {
    asm volatile("s_waitcnt vmcnt(0)" ::: "memory");
    __syncthreads();
    if (threadIdx.x == 0) {
        unsigned* bar = b.bar;
        __builtin_amdgcn_s_waitcnt(0);
        const unsigned nloc = b.st[0];
        const unsigned old = xb_add(&bar[XB_XSUB(b.x)], 1u);
        const unsigned gen = old / nloc;
        if (old + 1u == (gen + 1u) * nloc) xb_add(&bar[XB_XGEN(b.x)], 1u);
        else XB_SPIN(xb_ld(&bar[XB_XGEN(b.x)]) == gen, bar);
        __builtin_amdgcn_fence(__ATOMIC_ACQUIRE, "agent");
        asm volatile("s_waitcnt vmcnt(0)" ::: "memory");
    }
    __syncthreads();
}
using pg8::bf_lo; using pg8::bf_hi; using pg8::sigm; using pg8::gelu_t;
struct Args { const float* in[28]; float* out; unsigned char* ws; int ph_lo, ph_hi; };
typedef const __attribute__((address_space(4))) Args* KArgsP;
__device__ __forceinline__ KArgsP fresh_args() { KArgsP p = (KArgsP)__builtin_amdgcn_kernarg_segment_ptr(); asm volatile("" : "+s"(p)); return p; }

__device__ __forceinline__ float wave_sum(float v) {
#pragma unroll
    for (int o = 1; o < 64; o <<= 1) v += __shfl_xor(v, o);
    return v;
}
__device__ __forceinline__ void transpose_item(const float* W, int K, int N, const float* gk, bf16* WT, LAS float* scr, int item, int lane, int rmap = 0) {
    const int nblk = N / 32, kb = item / nblk, nb = item % nblk, k0 = 64 * kb, n0 = 32 * nb;
    { const int kr = lane >> 3, nq = lane & 7; f32x4 v[8];
#pragma unroll
      for (int i = 0; i < 8; ++i) v[i] = *(const GAS f32x4*)(W + (size_t)(k0 + kr + 8 * i) * N + n0 + 4 * nq);
#pragma unroll
      for (int i = 0; i < 8; ++i) { const int kk = kr + 8 * i; const float gs = gk ? gk[k0 + kk] : 1.0f; LAS float* d = scr + kk * 33 + 4 * nq; d[0] = v[i].x * gs; d[1] = v[i].y * gs; d[2] = v[i].z * gs; d[3] = v[i].w * gs; } }
    LDS_WAIT(); asm volatile("" ::: "memory");
    const int c = lane & 7;
#pragma unroll
    for (int j = 0; j < 4; ++j) { const int n = (lane >> 3) + 8 * j; const LAS float* s = scr + (8 * c) * 33 + n;
        v4u o; o.x = pk2(s[0 * 33], s[1 * 33]); o.y = pk2(s[2 * 33], s[3 * 33]); o.z = pk2(s[4 * 33], s[5 * 33]); o.w = pk2(s[6 * 33], s[7 * 33]);
        int nd = n0;
        if (rmap == 1) nd = (n0 < DFF) ? 256 * (n0 / 128) + (n0 % 128) : 256 * ((n0 - DFF) / 128) + 128 + ((n0 - DFF) % 128);
        if (rmap == 2 && n0 < 2048) nd = 256 * (n0 / 256) + 128 * ((n0 % 64) / 32) + 32 * ((n0 % 256) / 64);
        if (rmap == 2 && n0 >= 4096) { const int c = (n0 - 4096) % 2048; nd = 4096 + 256 * (c / 128) + (c % 128) + (n0 >= 6144 ? 128 : 0); }
        *(GAS v4u*)(WT + (size_t)(nd + n) * K + k0 + 8 * c) = o; }
    LDS_WAIT(); asm volatile("" ::: "memory");
}
constexpr int CONV_I_IN = (DM / 64) * (NIN / 32);
__device__ __forceinline__ void ph_convert(KArgsP ap, LAS unsigned char* lds, int l, int gw, int NGW, int wave, int lane, int it_lo = 0, int it_hi = 1 << 30) {
    LAS float* scr = (LAS float*)(lds + wave * 16384);
    unsigned char* ws = ap->ws;
    constexpr int I_IN = (DM / 64) * (NIN / 32), I_GLU = (DS / 64) * (DS / 32), I_BA = (DS / 64) * (DM / 32), I_OUT = (DM / 64) * (DM / 32), I_UP = (DM / 64) * (NUP / 32), I_DN = (DFF / 64) * (DM / 32);
    constexpr int NITEMS = I_IN + I_GLU + 2 * I_BA + I_OUT + I_UP + I_DN;
    static_assert(I_IN == CONV_I_IN, "");
    if (it_hi > NITEMS) it_hi = NITEMS;
    for (int it = it_lo + gw; it < it_hi; it += NGW) {
        int r = it;
        if (r < I_IN)  { transpose_item(ap->in[2] + (size_t)l * DM * NIN, DM, NIN, ap->in[1] + (size_t)l * DM, (bf16*)(ws + WS_WIN), scr, r, lane, 2); continue; } r -= I_IN;
        if (r < I_GLU) { transpose_item(ap->in[18] + (size_t)l * DS * DS, DS, DS, nullptr, (bf16*)(ws + WS_WGLU), scr, r, lane); continue; } r -= I_GLU;
        if (r < I_BA)  { transpose_item(ap->in[20] + (size_t)l * DS * DM, DS, DM, nullptr, (bf16*)(ws + WS_WBA), scr, r, lane); continue; } r -= I_BA;
        if (r < I_BA)  { transpose_item(ap->in[21] + (size_t)l * DS * DM, DS, DM, nullptr, (bf16*)(ws + WS_WBS), scr, r, lane); continue; } r -= I_BA;
        if (r < I_OUT) { transpose_item(ap->in[22] + (size_t)l * DM * DM, DM, DM, nullptr, (bf16*)(ws + WS_WOUT), scr, r, lane); continue; } r -= I_OUT;
        if (r < I_UP)  { transpose_item(ap->in[24] + (size_t)l * DM * NUP, DM, NUP, ap->in[23] + (size_t)l * DM, (bf16*)(ws + WS_WUP), scr, r, lane, 1); continue; } r -= I_UP;
        transpose_item(ap->in[27] + (size_t)l * DFF * DM, DFF, DM, nullptr, (bf16*)(ws + WS_WDN), scr, r, lane);
    }
}
__device__ __forceinline__ void ph_xprep(const float* src, bf16* xb, float* ssq, int gw, int NGW, int lane) {
    for (int m = gw; m < MR; m += NGW) {
        const GAS f32x4* xr = (const GAS f32x4*)(src + (size_t)m * DM) + lane;
        f32x4 v[8]; float s = 0.f;
#pragma unroll
        for (int j = 0; j < 8; ++j) { v[j] = xr[64 * j]; s += (v[j].x * v[j].x + v[j].y * v[j].y) + (v[j].z * v[j].z + v[j].w * v[j].w); }
        s = wave_sum(s);
        if (lane < 32) ssq[(size_t)m * 32 + lane] = (lane == 0) ? s : 0.f;
        GAS unsigned long long* o8 = (GAS unsigned long long*)(xb + (size_t)m * DM) + lane;
#pragma unroll
        for (int j = 0; j < 8; ++j) { const unsigned h0 = pk2(v[j].x, v[j].y), h1 = pk2(v[j].z, v[j].w); o8[64 * j] = (unsigned long long)h0 | ((unsigned long long)h1 << 32); }
    }
}
__device__ __forceinline__ void ph_conv_fix(KArgsP ap, int l, int vcu, int G, int tid) {
    const bf16* RAW = (const bf16*)(ap->ws + WS_RAW); bf16* Gb = (bf16*)(ap->ws + WS_G);
    const float* cw = ap->in[25] + (size_t)l * 3 * NUP; const float* cb = ap->in[26] + (size_t)l * NUP;
    constexpr int NF8 = DFF / 8; constexpr long total = (long)(MR / 256) * 4 * NF8;
    const bool grp = (G % 8 == 0); const int per = grp ? G / 8 : G; const long it0 = grp ? (long)(vcu / per) * (total / 8) : 0, it1 = grp ? it0 + total / 8 : total, NT = (long)per * NTHR;
    for (long it = it0 + (long)(grp ? vcu % per : vcu) * NTHR + tid; it < it1; it += NT) {
        const int f = (int)(it % NF8) * 8, q = (int)(it / NF8), r = q & 1, which = (q >> 1) & 1, pm = q >> 2;
        float av[8], vv[8];
        { const f32x4 b0 = *(const f32x4*)(cb + f), b1 = *(const f32x4*)(cb + f + 4), b2 = *(const f32x4*)(cb + DFF + f), b3 = *(const f32x4*)(cb + DFF + f + 4);
          av[0] = b0.x; av[1] = b0.y; av[2] = b0.z; av[3] = b0.w; av[4] = b1.x; av[5] = b1.y; av[6] = b1.z; av[7] = b1.w;
          vv[0] = b2.x; vv[1] = b2.y; vv[2] = b2.z; vv[3] = b2.w; vv[4] = b3.x; vv[5] = b3.y; vv[6] = b3.z; vv[7] = b3.w; }
#pragma unroll
        for (int jj = 0; jj < 3; ++jj) {
            const int sq = r + jj;
            const bf16* src;
            if (which == 1) src = RAW + ((size_t)pm * 8 + 2 + sq) * NUP;
            else if (sq >= 2) src = RAW + ((size_t)pm * 8 + (sq - 2)) * NUP;
            else { if ((pm & 7) == 0) continue; src = RAW + ((size_t)(pm - 1) * 8 + 6 + sq) * NUP; }
            const v4u wa = *(const GAS v4u*)(src + f), wv = *(const GAS v4u*)(src + DFF + f);
            const float* c0 = cw + (size_t)jj * NUP + f;
            const f32x4 ca0 = *(const f32x4*)c0, ca1 = *(const f32x4*)(c0 + 4), cv0 = *(const f32x4*)(c0 + DFF), cv1 = *(const f32x4*)(c0 + DFF + 4);
            av[0] += ca0.x * bf_lo(wa.x); av[1] += ca0.y * bf_hi(wa.x); av[2] += ca0.z * bf_lo(wa.y); av[3] += ca0.w * bf_hi(wa.y);
            av[4] += ca1.x * bf_lo(wa.z); av[5] += ca1.y * bf_hi(wa.z); av[6] += ca1.z * bf_lo(wa.w); av[7] += ca1.w * bf_hi(wa.w);
            vv[0] += cv0.x * bf_lo(wv.x); vv[1] += cv0.y * bf_hi(wv.x); vv[2] += cv0.z * bf_lo(wv.y); vv[3] += cv0.w * bf_hi(wv.y);
            vv[4] += cv1.x * bf_lo(wv.z); vv[5] += cv1.y * bf_hi(wv.z); vv[6] += cv1.z * bf_lo(wv.w); vv[7] += cv1.w * bf_hi(wv.w); }
        v4u o; o.x = pk2(gelu_t(av[0]) * vv[0], gelu_t(av[1]) * vv[1]); o.y = pk2(gelu_t(av[2]) * vv[2], gelu_t(av[3]) * vv[3]);
        o.z = pk2(gelu_t(av[4]) * vv[4], gelu_t(av[5]) * vv[5]); o.w = pk2(gelu_t(av[6]) * vv[6], gelu_t(av[7]) * vv[7]);
        *(GAS v4u*)(Gb + (size_t)(256 * pm + 128 * which + r) * DFF + f) = o;
    }
}
namespace att {
typedef short bf16x8 __attribute__((ext_vector_type(8)));
typedef short s16x4 __attribute__((ext_vector_type(4)));
typedef float f32x16 __attribute__((ext_vector_type(16)));
typedef unsigned u32x4 __attribute__((ext_vector_type(4)));
__device__ __forceinline__ int crow(int r, int hi) { return (r & 3) + 8 * (r >> 2) + 4 * hi; }
__device__ __forceinline__ s16x4 vtr(const LAS unsigned char* p) { return __builtin_bit_cast(s16x4, __builtin_amdgcn_ds_read_tr16_b64_v4i16((LAS s16x4*)p)); }
__device__ __forceinline__ void glds16(const void* gsrc, unsigned lds_dst) { unsigned keep;
    asm volatile("s_mov_b32 %0, m0\n\ts_mov_b32 m0, %2\n\ts_nop 0\n\tglobal_load_lds_dwordx4 %1, off\n\ts_mov_b32 m0, %0" : "=&s"(keep) : "v"(gsrc), "s"(lds_dst) : "memory"); }
__device__ __forceinline__ void glds16s(const void* base, unsigned voff, unsigned lds_dst) { unsigned keep;
    asm volatile("s_mov_b32 %0, m0\n\ts_mov_b32 m0, %3\n\ts_nop 0\n\tglobal_load_lds_dwordx4 %1, %2\n\ts_mov_b32 m0, %0" : "=&s"(keep) : "v"(voff), "s"(base), "s"(lds_dst) : "memory"); }
constexpr int WSF_OFF = LDSCTL_OFF + 1024;
}
__device__ __forceinline__ void ph_attn_mfma(KArgsP ap, LAS unsigned char* lds, int l, int vcu, int G, int wave, int lane) {
    using namespace att;
    const bf16* PROJ = (const bf16*)(ap->ws + WS_PROJ); bf16* ON = (bf16*)(ap->ws + WS_ON);
    const int r32 = lane & 31, hi = lane >> 5, c = wave >> 2, wq = wave & 3;
    const float s1 = wave_sum(ap->in[5][l * 64 + lane] * ap->in[6][l * 64 + lane]), s2 = wave_sum(ap->in[7][l * 64 + lane] * ap->in[8][l * 64 + lane]);
    const float lam_init = 0.8f - 0.6f * __builtin_amdgcn_exp2f(-0.3f * LOG2E * (float)l), lam = __builtin_amdgcn_exp2f(s1 * LOG2E) - __builtin_amdgcn_exp2f(s2 * LOG2E) + lam_init;
    const float* sg = ap->in[9] + l * 128;
    LAS float* XCH = (LAS float*)lds;
    LAS float* wsf = (LAS float*)(lds + WSF_OFF) + wave * 64;
    const unsigned lds0 = (unsigned)(uintptr_t)lds;
    const unsigned voffK = (unsigned)((lane * NIN + 2 * wave * 8) * 2);
    const unsigned voffV0 = (unsigned)(((16 * (2 * (wave & 1)) + (lane >> 2)) * NIN + (wave >> 1) * 32 + (lane & 3) * 8) * 2), voffV1 = voffV0 + (unsigned)(16 * NIN * 2);
    const int sper = (G % 8 == 0) ? G / 8 : G, sbase = (G % 8 == 0) ? (vcu / sper) * (NB * NH) : 0, slim = (G % 8 == 0) ? NB * NH : NB * NH * 8;
    for (int sl = (G % 8 == 0) ? vcu % sper : vcu; sl < slim; sl += sper) { const int su = sbase + sl;
        const int bh = su >> 3, pi = su & 7, b = bh >> 3, h = bh & 7;
        const float sl2 = __builtin_amdgcn_exp2f(-(float)(h + 1)) * LOG2E;
        const bf16* Kg = PROJ + (size_t)b * SEQ * NIN + OFF_K + h * 128;
        const bf16* Vg = PROJ + (size_t)b * SEQ * NIN + OFF_V + h * 128;
#pragma unroll 1
        for (int half = 0; half < 2; ++half) {
            const int qb = half ? 15 - pi : pi, NT = 2 * qb + 2, myNT = (wq < 2) ? NT - 1 : NT, q0 = 128 * qb;
            const bf16* Qw = PROJ + ((size_t)b * SEQ + q0 + 32 * wq + r32) * NIN + h * 128 + c * 64;
#define ATT_STAGE_K(tt) do { const bf16* kb2_ = Kg + (size_t)(64 * (tt)) * NIN; const unsigned ld_ = (unsigned)__builtin_amdgcn_readfirstlane((int)(lds0 + ((tt) & 3) * 32768 + 2 * wave * 1024)); \
                glds16s(kb2_, voffK, ld_); glds16s(kb2_, voffK + 16u, ld_ + 1024u); } while (0)
#define ATT_STAGE_V(tt) do { const bf16* vb2_ = Vg + (size_t)(64 * (tt)) * NIN; const unsigned ld_ = (unsigned)__builtin_amdgcn_readfirstlane((int)(lds0 + ((tt) & 3) * 32768 + 16384 + 2 * wave * 1024)); \
                glds16s(vb2_, voffV0, ld_); glds16s(vb2_, voffV1, ld_ + 1024u); } while (0)
#define ATT_QK(tt, P0, P1, C0, C1) do { const LAS unsigned char* kb_ = lds + ((tt) & 3) * 32768 + (8 * c + hi) * 1024 + r32 * 16; \
                bf16x8 kf_[8]; \
                _Pragma("unroll") for (int d0 = 0; d0 < 4; ++d0) { kf_[2 * d0] = *(const LAS bf16x8*)(kb_ + d0 * 2048); kf_[2 * d0 + 1] = *(const LAS bf16x8*)(kb_ + d0 * 2048 + 512); } \
                __builtin_amdgcn_sched_barrier(0); __builtin_amdgcn_s_setprio(1); \
                P0 = __builtin_amdgcn_mfma_f32_32x32x16_bf16(kf_[0], qr[0], C0, 0, 0, 0); P1 = __builtin_amdgcn_mfma_f32_32x32x16_bf16(kf_[1], qr[0], C1, 0, 0, 0); \
                _Pragma("unroll") for (int d0 = 1; d0 < 4; ++d0) { P0 = __builtin_amdgcn_mfma_f32_32x32x16_bf16(kf_[2 * d0], qr[d0], P0, 0, 0, 0); P1 = __builtin_amdgcn_mfma_f32_32x32x16_bf16(kf_[2 * d0 + 1], qr[d0], P1, 0, 0, 0); } \
                __builtin_amdgcn_s_setprio(0); __builtin_amdgcn_sched_barrier(0); } while (0)
            bf16x8 qr[4];
#pragma unroll
            for (int d0 = 0; d0 < 4; ++d0) qr[d0] = *(const bf16x8*)(Qw + d0 * 16 + hi * 8);
            asm volatile("" : "+v"(qr[0]), "+v"(qr[1]), "+v"(qr[2]), "+v"(qr[3]) :: "memory");
            ATT_STAGE_K(0); ATT_STAGE_V(0); ATT_STAGE_K(1); ATT_STAGE_V(1);
            if (NT > 2) { ATT_STAGE_K(2); ATT_STAGE_V(2); }
            f32x16 o[4];
#pragma unroll
            for (int d0 = 0; d0 < 4; ++d0)
#pragma unroll
                for (int r = 0; r < 16; ++r) o[d0][r] = 0.f;
            float mrun = 0.f, l_reg = 0.f;
            const float qd = (float)(q0 + 32 * wq + r32 - 4 * hi);
            f32x16 B0, B1;
#pragma unroll
            for (int r = 0; r < 16; ++r) { const float kr = (float)((r & 3) + 8 * (r >> 2)); B0[r] = -sl2 * (qd - kr); B1[r] = -sl2 * (qd - 32.0f - kr); }
            const float bstep = 64.0f * sl2;
#pragma unroll 1
            for (int t = 0; t < NT; ++t) {
                if (t + 2 < NT) asm volatile("s_waitcnt vmcnt(8) lgkmcnt(0)\n\ts_barrier" ::: "memory"); else asm volatile("s_waitcnt vmcnt(0) lgkmcnt(0)\n\ts_barrier" ::: "memory");
                if (t + 3 < NT) { ATT_STAGE_K(t + 3); ATT_STAGE_V(t + 3); }
                if (t < myNT) {
                    const LAS unsigned char* Vb = lds + (t & 3) * 32768 + 16384;
                    if (t == myNT - 1) {
                        const float dq = qd - (float)(64 * t);
#pragma unroll
                        for (int r = 0; r < 16; ++r) { const float kr = (float)((r & 3) + 8 * (r >> 2)); B0[r] = -sl2 * __builtin_fabsf(dq - kr) - mrun; B1[r] = -sl2 * __builtin_fabsf(dq - 32.0f - kr) - mrun; }
                    }
                    f32x16 p0, p1;
                    ATT_QK(t, p0, p1, B0, B1);
                    float rm = fmaxf(p0[0], p1[0]);
#pragma unroll
                    for (int r = 1; r < 16; ++r) rm = fmaxf(fmaxf(rm, p0[r]), p1[r]);
                    { auto rr = __builtin_amdgcn_permlane32_swap(__float_as_uint(rm), __float_as_uint(rm), false, false); rm = fmaxf(__uint_as_float(rr[0]), __uint_as_float(rr[1])); }
                    if (__builtin_amdgcn_ballot_w64(rm > 8.0f) != 0ull) {
                        const float dl = fmaxf(rm, 0.f), f = __builtin_amdgcn_exp2f(-dl); mrun += dl; l_reg *= f;
                        p0 = p0 - dl; p1 = p1 - dl; B0 = B0 - dl; B1 = B1 - dl;
                        if (hi == 0) wsf[r32] = f;
#pragma unroll
                        for (int r = 0; r < 16; ++r) { const float fr_ = wsf[crow(r, hi)];
#pragma unroll
                            for (int d0 = 0; d0 < 4; ++d0) o[d0][r] *= fr_; }
                    }
#pragma unroll
                    for (int r = 0; r < 16; ++r) { p0[r] = __builtin_amdgcn_exp2f(p0[r]); p1[r] = __builtin_amdgcn_exp2f(p1[r]); }
                    { const f32x16 sv = p0 + p1; float sacc = ((sv[0] + sv[1]) + (sv[2] + sv[3])) + ((sv[4] + sv[5]) + (sv[6] + sv[7])) + ((sv[8] + sv[9]) + (sv[10] + sv[11])) + ((sv[12] + sv[13]) + (sv[14] + sv[15])); l_reg += sacc; }
                    u32x4 pw[4];
#pragma unroll
                    for (int j = 0; j < 4; ++j) { pw[0][j] = pg8::cvt_pk_bf16(p0[2 * j], p0[2 * j + 1]); pw[1][j] = pg8::cvt_pk_bf16(p0[8 + 2 * j], p0[8 + 2 * j + 1]);
                        pw[2][j] = pg8::cvt_pk_bf16(p1[2 * j], p1[2 * j + 1]); pw[3][j] = pg8::cvt_pk_bf16(p1[8 + 2 * j], p1[8 + 2 * j + 1]); }
                    const LAS unsigned char* vp0 = Vb + ((lane >> 4) & 1) * 32 + (lane & 3) * 8 + (4 * hi + ((lane & 15) >> 2)) * 64;
                    { s16x4 vl[2][4], vh[2][4];
#pragma unroll
                      for (int ks = 0; ks < 4; ++ks) { vl[0][ks] = vtr(vp0 + ks * 1024); vh[0][ks] = vtr(vp0 + ks * 1024 + 512); }
                      __builtin_amdgcn_sched_barrier(0);
#pragma unroll
                      for (int d0 = 0; d0 < 4; ++d0) {
                          if (d0 < 3) {
#pragma unroll
                              for (int ks = 0; ks < 4; ++ks) { vl[(d0 + 1) & 1][ks] = vtr(vp0 + (d0 + 1) * 4096 + ks * 1024); vh[(d0 + 1) & 1][ks] = vtr(vp0 + (d0 + 1) * 4096 + ks * 1024 + 512); } }
                          __builtin_amdgcn_sched_barrier(0);
#pragma unroll
                          for (int ks = 0; ks < 4; ++ks) { const s16x4 a = vl[d0 & 1][ks], bq = vh[d0 & 1][ks]; const bf16x8 vf = (bf16x8){a[0], a[1], a[2], a[3], bq[0], bq[1], bq[2], bq[3]};
                              o[d0] = __builtin_amdgcn_mfma_f32_32x32x16_bf16(__builtin_bit_cast(bf16x8, pw[ks]), vf, o[d0], 0, 0, 0); }
                          __builtin_amdgcn_sched_barrier(0);
                      } }
                    B0 = B0 + bstep; B1 = B1 + bstep;
                }
            }
#undef ATT_STAGE_K
#undef ATT_STAGE_V
#undef ATT_QK
            { auto rr = __builtin_amdgcn_permlane32_swap(__float_as_uint(l_reg), __float_as_uint(l_reg), false, false); l_reg = __uint_as_float(rr[0]) + __uint_as_float(rr[1]); }
            if (hi == 0) wsf[r32] = __builtin_amdgcn_rcpf(l_reg);
            float il[16];
#pragma unroll
            for (int r = 0; r < 16; ++r) il[r] = wsf[crow(r, hi)];
            __syncthreads();
            if (c == 1) {
#pragma unroll
                for (int d0 = 0; d0 < 4; ++d0)
#pragma unroll
                    for (int r = 0; r < 16; ++r) XCH[(32 * wq + crow(r, hi)) * 128 + 32 * d0 + r32] = o[d0][r] * il[r]; }
            __syncthreads();
            if (c == 0) {
#pragma unroll
                for (int d0 = 0; d0 < 4; ++d0)
#pragma unroll
                    for (int r = 0; r < 16; ++r) { const int ix = (32 * wq + crow(r, hi)) * 128 + 32 * d0 + r32; XCH[ix] = o[d0][r] * il[r] - lam * XCH[ix]; } }
            __syncthreads();
            { const int row = 16 * wave + (lane >> 2), qq = lane & 3;
              const LAS f32x4* xp = (const LAS f32x4*)(XCH + row * 128 + 32 * qq);
              f32x4 x[8]; float ss = 0.f;
#pragma unroll
              for (int i = 0; i < 8; ++i) { x[i] = xp[i]; ss += (x[i].x * x[i].x + x[i].y * x[i].y) + (x[i].z * x[i].z + x[i].w * x[i].w); }
              ss += __shfl_xor(ss, 1); ss += __shfl_xor(ss, 2);
              const float sc = __builtin_amdgcn_rsqf(ss * (1.0f / 128.0f) + EPS) * (1.0f - lam_init);
              GAS v4u* op = (GAS v4u*)(ON + ((size_t)b * SEQ + q0 + row) * DS + h * 128 + 32 * qq);
#pragma unroll
              for (int i = 0; i < 4; ++i) { const f32x4 g0 = *(const f32x4*)(sg + 32 * qq + 8 * i), g1 = *(const f32x4*)(sg + 32 * qq + 8 * i + 4); const f32x4 xa = x[2 * i], xb = x[2 * i + 1]; v4u w;
                  w.x = pk2(xa.x * sc * g0.x, xa.y * sc * g0.y); w.y = pk2(xa.z * sc * g0.z, xa.w * sc * g0.w); w.z = pk2(xb.x * sc * g1.x, xb.y * sc * g1.y); w.w = pk2(xb.z * sc * g1.z, xb.w * sc * g1.w); op[i] = w; } }
            __syncthreads();
        }
    }
    __syncthreads();
}
struct SsmPar { float dt, ar, ai, ph1; };
__device__ __forceinline__ SsmPar ssm_par(KArgsP ap, int l, int g, int p) {
    SsmPar q; q.dt = __builtin_amdgcn_exp2f(ap->in[12][(size_t)l * NG + g] * LOG2E); q.ar = ap->in[10][((size_t)l * NG + g) * NPS + p]; q.ai = ap->in[11][((size_t)l * NG + g) * NPS + p];
    q.ph1 = q.dt * q.ai * 0.15915494309189535f; return q;
}
__device__ __forceinline__ void ssm_apow(const SsmPar& q, float n, float& re, float& im) {
    const float mag = __builtin_amdgcn_exp2f(n * q.dt * q.ar * LOG2E), ph = __builtin_amdgcn_fractf(n * q.ph1);
    re = mag * __builtin_amdgcn_cosf(ph); im = mag * __builtin_amdgcn_sinf(ph);
}
__device__ __forceinline__ void ssm_f(const SsmPar& q, float& fre, float& fim) {
    float a1r, a1i; ssm_apow(q, 1.0f, a1r, a1i);
    const float iden = __builtin_amdgcn_rcpf(q.ar * q.ar + q.ai * q.ai), zr = a1r - 1.0f, zi = a1i; fre = (zr * q.ar + zi * q.ai) * iden; fim = (zi * q.ar - zr * q.ai) * iden;
}
__device__ __forceinline__ void ph_ssm_prep1(KArgsP ap, LAS unsigned char* lds, int l, int gw, int NGW, int wave, int lane) {
    float* Ktab = (float*)(ap->ws + WS_KTAB);
    const float* bre = ap->in[13] + (size_t)l * NG * NPS * NIS; const float* bim = ap->in[14] + (size_t)l * NG * NPS * NIS;
    const float* cre = ap->in[15] + (size_t)l * NG * NIS * NPS; const float* cim = ap->in[16] + (size_t)l * NG * NIS * NPS;
    LAS float* scr = (LAS float*)(lds + wave * 16384);
    for (int it = gw; it < NG * 16; it += NGW) {
        const int g = it >> 4, tau = it & 15;
#pragma unroll
        for (int j = 0; j < 4; ++j) { const int e4 = 4 * (lane + 64 * j);
            *(LAS f32x4*)(scr + e4) = *(const GAS f32x4*)(cre + g * 1024 + e4); *(LAS f32x4*)(scr + 1024 + e4) = *(const GAS f32x4*)(cim + g * 1024 + e4);
            *(LAS f32x4*)(scr + 2048 + e4) = *(const GAS f32x4*)(bre + g * 1024 + e4); *(LAS f32x4*)(scr + 3072 + e4) = *(const GAS f32x4*)(bim + g * 1024 + e4); }
        const SsmPar q = ssm_par(ap, l, g, lane);
        float fr_, fi_, tr_, ti_; ssm_f(q, fr_, fi_); ssm_apow(q, (float)tau, tr_, ti_);
        const float Er = tr_ * fr_ - ti_ * fi_, Ei = tr_ * fi_ + ti_ * fr_;
        LDS_WAIT(); asm volatile("" ::: "memory");
        float acc[4] = {0.f, 0.f, 0.f, 0.f}; const int o0 = lane >> 4, i = lane & 15;
#pragma unroll 1
        for (int p4 = 0; p4 < NPS; p4 += 4) {
            f32x4 crv[4], civ[4];
#pragma unroll
            for (int k = 0; k < 4; ++k) { crv[k] = *(const LAS f32x4*)(scr + (o0 + 4 * k) * 64 + p4); civ[k] = *(const LAS f32x4*)(scr + 1024 + (o0 + 4 * k) * 64 + p4); }
#pragma unroll
            for (int pp = 0; pp < 4; ++pp) { const int p = p4 + pp;
                const float er = __builtin_bit_cast(float, __builtin_amdgcn_readlane(__builtin_bit_cast(int, Er), p)), ei = __builtin_bit_cast(float, __builtin_amdgcn_readlane(__builtin_bit_cast(int, Ei), p));
                const float br = scr[2048 + p * 16 + i], bi = scr[3072 + p * 16 + i];
#pragma unroll
                for (int k = 0; k < 4; ++k) { const float cr = crv[k][pp], ci = civ[k][pp], zr = cr * er - ci * ei, zi = cr * ei + ci * er; acc[k] += zr * br - zi * bi; } }
        }
#pragma unroll
        for (int k = 0; k < 4; ++k) Ktab[(size_t)(g * 16 + tau) * 256 + lane + 64 * k] = acc[k];
        LDS_WAIT(); asm volatile("" ::: "memory");
    }
}
__device__ __forceinline__ void ph_ssm_prep2(KArgsP ap, int l, long gtid, long NT) {
    const float* Ktab = (const float*)(ap->ws + WS_KTAB); bf16* BtY = (bf16*)(ap->ws + WS_BTY); bf16* BtS = (bf16*)(ap->ws + WS_BTS);
    const float* bre = ap->in[13] + (size_t)l * NG * NPS * NIS; const float* bim = ap->in[14] + (size_t)l * NG * NPS * NIS;
    const float* cre = ap->in[15] + (size_t)l * NG * NIS * NPS; const float* cim = ap->in[16] + (size_t)l * NG * NIS * NPS; const float* dsk = ap->in[17] + (size_t)l * DS;
    constexpr long NY = (long)NG * 256 * 48, NS = (long)NG * 256 * 32;
    for (long it = gtid; it < NY + NS; it += NT) {
        float v[8];
        if (it < NY) {
            const int g = (int)(it / (256 * 48)), rem = (int)(it % (256 * 48)), n = rem / 48, k0 = (rem % 48) * 8, j = n >> 4, o = n & 15;
            if (k0 < 256) { const int s = k0 >> 4, i0 = k0 & 15;
#pragma unroll
                for (int e = 0; e < 8; ++e) { float x = 0.f; if (s <= j) x = Ktab[(size_t)(g * 16 + (j - s)) * 256 + o * 16 + i0 + e]; if (s == j && i0 + e == o) x += dsk[g * NIS + o]; v[e] = x; }
            } else { const int kk = k0 - 256;
#pragma unroll
                for (int e = 0; e < 8; ++e) { const int p = (kk + e) >> 1; const bool im = (e & 1) != 0; const SsmPar q = ssm_par(ap, l, g, p); float pr, pi_; ssm_apow(q, (float)(j + 1), pr, pi_);
                    const float cr = cre[(size_t)(g * NIS + o) * NPS + p], ci = cim[(size_t)(g * NIS + o) * NPS + p]; v[e] = im ? -(cr * pi_ + ci * pr) : (cr * pr - ci * pi_); } }
            v4u w; w.x = pk2(v[0], v[1]); w.y = pk2(v[2], v[3]); w.z = pk2(v[4], v[5]); w.w = pk2(v[6], v[7]);
            *(GAS v4u*)(BtY + ((size_t)g * 256 + n) * 384 + k0) = w;
        } else {
            const long r2 = it - NY; const int g = (int)(r2 / (256 * 32)), rem = (int)(r2 % (256 * 32)), n = rem / 32, k0 = (rem % 32) * 8;
            if (n < 128) { const int p = n >> 1, s = k0 >> 4, i0 = k0 & 15; const bool im = (n & 1) != 0;
                const SsmPar q = ssm_par(ap, l, g, p); float fr_, fi_, tr_, ti_; ssm_f(q, fr_, fi_); ssm_apow(q, (float)(15 - s), tr_, ti_);
                const float Er = tr_ * fr_ - ti_ * fi_, Ei = tr_ * fi_ + ti_ * fr_;
#pragma unroll
                for (int e = 0; e < 8; ++e) { const float br = bre[(size_t)(g * NPS + p) * NIS + i0 + e], bi = bim[(size_t)(g * NPS + p) * NIS + i0 + e]; v[e] = im ? (Er * bi + Ei * br) : (Er * br - Ei * bi); }
            } else {
#pragma unroll
                for (int e = 0; e < 8; ++e) v[e] = 0.f; }
            v4u w; w.x = pk2(v[0], v[1]); w.y = pk2(v[2], v[3]); w.z = pk2(v[4], v[5]); w.w = pk2(v[6], v[7]);
            *(GAS v4u*)(BtS + ((size_t)g * 256 + n) * 256 + k0) = w;
        }
    }
}
__device__ __forceinline__ void ssm_scan_unit(KArgsP ap, LAS unsigned char* lds, int l, int g, int b, int par, int wave, int lane) {
    const SsmPar q = ssm_par(ap, l, g, lane); float cr, ci, dr, di; ssm_apow(q, 16.0f, cr, ci); ssm_apow(q, 256.0f, dr, di);
    const unsigned* Sp = (const unsigned*)(ap->ws + WS_S) + ((size_t)g * 2048 + b * 128 + 16 * wave) * 64 + lane;
    unsigned* Up = (unsigned*)((bf16*)(ap->ws + WS_UCAT) + ((size_t)g * 2048 + b * 128 + 16 * wave) * 384 + 256) + lane;
    unsigned sv[16];
#pragma unroll
    for (int j = 0; j < 16; ++j) sv[j] = Sp[(size_t)j * 64];
    float tr = 0.f, ti = 0.f;
#pragma unroll
    for (int j = 0; j < 16; ++j) { const float nr = cr * tr - ci * ti + pg8::bf_lo(sv[j]), ni = cr * ti + ci * tr + pg8::bf_hi(sv[j]); tr = nr; ti = ni; }
    LAS float* T = (LAS float*)(lds + par * 4096);
    T[wave * 128 + lane] = tr; T[wave * 128 + 64 + lane] = ti;
    __syncthreads();
    float hr = 0.f, hi = 0.f;
    for (int v = 0; v < wave; ++v) { const float xr = T[v * 128 + lane], xi = T[v * 128 + 64 + lane]; const float nr = dr * hr - di * hi + xr, ni = dr * hi + di * hr + xi; hr = nr; hi = ni; }
#pragma unroll
    for (int j = 0; j < 16; ++j) {
        Up[(size_t)j * 192] = pg8::cvt_pk_bf16(hr, hi);
        const float nr = cr * hr - ci * hi + pg8::bf_lo(sv[j]), ni = cr * hi + ci * hr + pg8::bf_hi(sv[j]); hr = nr; hi = ni;
    }
}
__device__ __forceinline__ void ph_ssm_scan(KArgsP ap, LAS unsigned char* lds, int l, int vcu, int G, int wave, int lane) {
    int par = 0;
    for (int u = vcu; u < NB * NG; u += G) { ssm_scan_unit(ap, lds, l, u % NG, u / NG, par, wave, lane); par ^= 1; }
}
constexpr int RTAB_OFF = LDSCTL_OFF + 4096;
template <class Sched> __device__ __forceinline__ pg8::RstdTab build_rstd_tab(LAS unsigned char* lds, const Sched& S, const float* ssq, int tid) {
    pg8::RstdTab R; R.tab = (const LAS float*)(lds + RTAB_OFF); R.ssq = ssq; R.p0 = R.p1 = R.p2 = R.p3 = -1;
    int np = 0; pg8::Unit u;
    for (int i = 0; S.next(i, u); ++i) if (u.pm != R.p0 && u.pm != R.p1 && u.pm != R.p2 && u.pm != R.p3) { if (np == 0) R.p0 = u.pm; else if (np == 1) R.p1 = u.pm; else if (np == 2) R.p2 = u.pm; else if (np == 3) R.p3 = u.pm; ++np; }
    LAS float* tab = (LAS float*)(lds + RTAB_OFF);
#pragma unroll
    for (int pass = 0; pass < 2; ++pass) { const int k = 2 * pass + (tid >> 8); const int pm = (k == 0) ? R.p0 : (k == 1) ? R.p1 : (k == 2) ? R.p2 : R.p3;
        if (pm >= 0) { const GAS f32x4* sp = (const GAS f32x4*)(ssq + ((size_t)pm * 256 + (tid & 255)) * 32); float sm = 0.f;
#pragma unroll
            for (int j = 0; j < 8; ++j) { const f32x4 v = sp[j]; sm += (v.x + v.y) + (v.z + v.w); }
            tab[k * 256 + (tid & 255)] = __builtin_amdgcn_rsqf(sm * (1.0f / DM) + EPS); } }
    __syncthreads();
    return R;
}
#ifndef MK_PER_PHASE
#define MK_PER_PHASE 0
#endif
#define PH_LOCALS \
    KArgsP ap = fresh_args(); \
    int tid = threadIdx.x; asm volatile("" : "+v"(tid)); \
    const int lane = tid & 63, wave = __builtin_amdgcn_readfirstlane(tid >> 6); \
    int G = gridDim.x, bx = __builtin_amdgcn_readfirstlane(((volatile LAS int*)(lds + MISC_OFF))[12]); asm volatile("" : "+s"(G), "+s"(bx)); \
    const int vcu = (G % 8 == 0) ? (bx % 8) * (G / 8) + bx / 8 : bx, gw = vcu * NWAVES + wave, NGW = G * NWAVES; \
    unsigned char* const ws = ap->ws; (void)lane; (void)gw; (void)NGW; (void)ws; (void)vcu
__global__ void __launch_bounds__(NTHR, 2) fwd_kernel(Args a) {
    extern __shared__ __attribute__((aligned(16))) unsigned char lds_raw[];
    LAS unsigned char* lds = (LAS unsigned char*)lds_raw;
    for (int u = threadIdx.x; u < (LDS_BYTES - LDSCTL_OFF) / 4; u += NTHR) ((LAS unsigned*)(lds + LDSCTL_OFF))[u] = 0u;
    __syncthreads();
    (void)xcd_barrier_post((unsigned*)(fresh_args()->ws + WS_CTL) + CW_BAR, (volatile LAS unsigned*)(lds + MISC_OFF) + 8);
    if (threadIdx.x == 0) ((volatile LAS int*)(lds + MISC_OFF))[12] = (int)blockIdx.x;
    __syncthreads();
    const int lo = a.ph_lo, hi = a.ph_hi;
#define IN(k) (lo <= (k) && (k) < hi)
#define SEAM(k) do { if (IN(k) && IN((k) + 1)) { XcdBarrier b_; b_.bar = (unsigned*)(fresh_args()->ws + WS_CTL) + CW_BAR; b_.x = xb_xcc_id(); b_.st = (volatile LAS unsigned*)(lds + MISC_OFF) + 8; xcd_barrier(b_); } } while (0)
#define GEMM_PHASE(EpiT, Eobj, Aptr, Bptr, Nv, Kv) do { pg8::Gemm g_{(const pg8::bf16_t*)(Aptr), (const pg8::bf16_t*)(Bptr), MR, (Nv), (Kv), (Kv), (Kv), nullptr, nullptr}; pg8::StaticOrder S_; S_.init(MR, (Nv), G, bx); \
        pg8::gemm_phase<EpiT, pg8::StaticOrder, true, true>(lds, g_, S_, Eobj); } while (0)
#define SEAM_L(k) do { if (IN(k) && IN((k) + 1)) { XcdBarrier b_; b_.bar = (unsigned*)(fresh_args()->ws + WS_CTL) + CW_BAR; b_.x = xb_xcc_id(); b_.st = (volatile LAS unsigned*)(lds + MISC_OFF) + 8; \
        if (b_.st[2]) xcd_barrier_local(b_); else xcd_barrier(b_); } } while (0)
#define WSP(T, off) ((T*)(ws + (off)))

    if (IN(0)) { PH_LOCALS; ph_convert(ap, lds, 0, gw, NGW, wave, lane); ph_ssm_prep1(ap, lds, 0, gw, NGW, wave, lane); ph_xprep(ap->in[0], WSP(bf16, WS_XB), WSP(float, WS_RSTD), gw, NGW, lane); }
    SEAM(0);
    { volatile LAS unsigned* st_ = (volatile LAS unsigned*)(lds + MISC_OFF) + 8; if (threadIdx.x == 0 && st_[2]) ((volatile LAS int*)(lds + MISC_OFF))[12] = (int)(st_[3] * 8u + xb_xcc_id()); __syncthreads(); }
    for (int l = 0; l < NL; ++l) {
        const int p0 = 1 + PH_PER_LAYER * l;
        if (IN(p0 + 0)) { PH_LOCALS; { pg8::StaticOrder S0_; S0_.init(MR, NIN, G, bx); const pg8::RstdTab rt_ = build_rstd_tab(lds, S0_, WSP(float, WS_RSTD), tid);
              pg8::EpiWin E{WSP(pg8::bf16_t, WS_PROJ), WSP(pg8::bf16_t, WS_UCAT), rt_, ap->in[3] + l * 64, ap->in[4] + l * 64, QSCALE}; GEMM_PHASE(pg8::EpiWin, E, ws + WS_XB, ws + WS_WIN, NIN, DM); }

                                    ph_ssm_prep2(ap, l, (long)vcu * NTHR + tid, (long)G * NTHR); }
        SEAM(p0 + 0);
        if (IN(p0 + 1)) { PH_LOCALS;
            ph_attn_mfma(ap, lds, l, vcu, G, wave, lane);
            VM_WAIT(); __syncthreads();
            { pg8::Gemm g_{(const pg8::bf16_t*)(ws + WS_UCAT), (const pg8::bf16_t*)(ws + WS_BTS), NG * 2048, 256, 256, 384, 256, nullptr, nullptr}; pg8::GroupOrder S_{NG * 8, G, bx, 8}; pg8::EpiSsmS E{WSP(pg8::bf16_t, WS_S)};
              pg8::gemm_phase<pg8::EpiSsmS, pg8::GroupOrder, true, true>(lds, g_, S_, E); }
            VM_WAIT(); __syncthreads();
            { int par = 0; for (int L = bx; L < NG * 8; L += G) { ssm_scan_unit(ap, lds, l, L >> 3, 2 * (L & 7), par, wave, lane); ssm_scan_unit(ap, lds, l, L >> 3, 2 * (L & 7) + 1, par ^ 1, wave, lane); } }
            VM_WAIT(); __syncthreads();
            { pg8::Gemm g_{(const pg8::bf16_t*)(ws + WS_UCAT), (const pg8::bf16_t*)(ws + WS_BTY), NG * 2048, 256, 384, 384, 384, nullptr, nullptr}; pg8::GroupOrder S_{NG * 8, G, bx, 8}; pg8::EpiSsmY E{WSP(bf16, WS_YG)};
              pg8::gemm_phase<pg8::EpiSsmY, pg8::GroupOrder, true, true>(lds, g_, S_, E); }
        }
        SEAM_L(p0 + 1);
        if (IN(p0 + 2)) { PH_LOCALS; pg8::EpiGlu E{WSP(bf16, WS_Y2), WSP(bf16, WS_YG), DS, ap->in[19] + (size_t)l * DS}; GEMM_PHASE(pg8::EpiGlu, E, ws + WS_YG, ws + WS_WGLU, DS, DS); }
        SEAM_L(p0 + 2);
        if (IN(p0 + 3)) { PH_LOCALS; pg8::Gemm g_{(const pg8::bf16_t*)(ws + WS_ON), (const pg8::bf16_t*)(ws + WS_WBA), MR, DM, DS, DS, DS, (const pg8::bf16_t*)(ws + WS_Y2), (const pg8::bf16_t*)(ws + WS_WBS)};
            pg8::TwoSegOrder S_; S_.base.init(MR, DM, G, bx); pg8::EpiGateF E{WSP(pg8::bf16_t, WS_MIX), DM, (const unsigned char*)(WSP(pg8::bf16_t, WS_PROJ) + OFF_GA), NIN * 2};
            pg8::gemm_phase<pg8::EpiGateF, pg8::TwoSegOrder, true, true>(lds, g_, S_, E); }
        SEAM_L(p0 + 3);
        if (IN(p0 + 4)) { PH_LOCALS; pg8::EpiResid E{WSP(pg8::bf16_t, WS_XB), WSP(float, WS_RSTD), nullptr}; GEMM_PHASE(pg8::EpiResid, E, ws + WS_MIX, ws + WS_WOUT, DM, DM);
        }
        SEAM(p0 + 4);
        if (IN(p0 + 5)) { PH_LOCALS; pg8::StaticOrder S0_; S0_.init(MR, NUP, G, bx); const pg8::RstdTab rt_ = build_rstd_tab(lds, S0_, WSP(float, WS_RSTD), tid);
            pg8::EpiUpConv E{WSP(pg8::bf16_t, WS_G), WSP(pg8::bf16_t, WS_RAW), rt_, ap->in[25] + (size_t)l * 3 * NUP, ap->in[26] + (size_t)l * NUP}; GEMM_PHASE(pg8::EpiUpConv, E, ws + WS_XB, ws + WS_WUP, NUP, DM);
            { const int nwg_ = (MR / 256) * (NUP / 256), rem_ = nwg_ % G; if (rem_ != 0 && bx >= rem_ && l + 1 < NL) ph_convert(ap, lds, l + 1, (bx - rem_) * NWAVES + wave, (G - rem_) * NWAVES, wave, lane, 0, CONV_I_IN); } }
        SEAM_L(p0 + 5);
        if (IN(p0 + 6)) { PH_LOCALS; ph_conv_fix(ap, l, vcu, G, tid); }
        SEAM_L(p0 + 6);
        if (IN(p0 + 7)) { PH_LOCALS; pg8::EpiResid E{WSP(pg8::bf16_t, WS_XB), WSP(float, WS_RSTD), (l == NL - 1) ? ap->out : nullptr}; GEMM_PHASE(pg8::EpiResid, E, ws + WS_G, ws + WS_WDN, DM, DFF); }
        SEAM(p0 + 7);
        if (IN(p0 + 8) && l + 1 < NL) { PH_LOCALS; ph_convert(ap, lds, l + 1, gw, NGW, wave, lane, (((MR / 256) * (NUP / 256)) % G != 0) ? CONV_I_IN : 0); ph_ssm_prep1(ap, lds, l + 1, gw, NGW, wave, lane); }
        SEAM(p0 + 8);
    }
#undef IN
#undef SEAM
#undef GEMM_PHASE
}

extern "C" void kernel_launch(void* const* d_in, const int* in_sizes, int n_in, void* d_out, int out_size, void* d_ws, size_t ws_size, hipStream_t stream) {
    static int grid = 0;
    if (grid == 0) {
        if (n_in != 28 || in_sizes[0] != MR * DM || out_size != MR * DM || ws_size < WS_END) { fprintf(stderr, "kernel_launch: unexpected shapes / workspace (n_in %d, ws %zu, need %zu); nothing launched\n", n_in, ws_size, (size_t)WS_END); grid = -1; return; }
        int dev = 0, cus = 0, per_cu = 0;
        if (hipGetDevice(&dev) != hipSuccess || hipDeviceGetAttribute(&cus, hipDeviceAttributeMultiprocessorCount, dev) != hipSuccess) { grid = -1; return; }
        if (hipFuncSetAttribute((const void*)fwd_kernel, hipFuncAttributeMaxDynamicSharedMemorySize, LDS_BYTES) != hipSuccess) { fprintf(stderr, "kernel_launch: hipFuncSetAttribute failed\n"); grid = -1; return; }
        if (hipOccupancyMaxActiveBlocksPerMultiprocessor(&per_cu, (const void*)fwd_kernel, NTHR, LDS_BYTES) != hipSuccess || per_cu < 1) { fprintf(stderr, "kernel_launch: occupancy query says %d\n", per_cu); }
        (void)hipGetLastError();
        grid = cus;
    }
    if (grid < 0) return;
    if (hipMemsetAsync((char*)d_ws + WS_CTL, 0, CTL_ZERO_BYTES, stream) != hipSuccess) return;
    Args a{};
    for (int i = 0; i < 28; ++i) a.in[i] = (const float*)d_in[i];
    a.out = (float*)d_out; a.ws = (unsigned char*)d_ws;
#if MK_PER_PHASE
    for (int ph = 0; ph < N_PHASES - 1; ++ph) { a.ph_lo = ph; a.ph_hi = ph + 1; hipLaunchKernelGGL(fwd_kernel, dim3(grid), dim3(NTHR), LDS_BYTES, stream, a); }
#else
    a.ph_lo = 0; a.ph_hi = N_PHASES;
    hipLaunchKernelGGL(fwd_kernel, dim3(grid), dim3(NTHR), LDS_BYTES, stream, a);
#endif
    const hipError_t le = hipPeekAtLastError();
    if (le != hipSuccess) fprintf(stderr, "kernel_launch: launch failed: %s\n", hipGetErrorName(le));
}
```
